# Optimizing an MI355X kernel written in HIP

```python
import math
import jax, jax.numpy as jnp
from jax import lax
import numpy as np

D_MODEL = 2048
BATCH = 8
SEQ = 2048
DEPTH = 1

ATT_HEADS = 16
ATT_KV_HEADS = 4
ATT_HEAD_DIM = 64
ATT_GROUP = ATT_HEADS // ATT_KV_HEADS
WINDOW = 128
ATT_BLOCK = 128
M_HEADS = 4
M_QK_DIM = 128
M_V_DIM = 256
M_CHUNK = 64
CONV_WIDTH = 4
D_FF = 5632
EPS = 1e-6

ATT_Q = ATT_HEADS * ATT_HEAD_DIM
ATT_KV = ATT_KV_HEADS * ATT_HEAD_DIM
M_QK = M_HEADS * M_QK_DIM
M_V = M_HEADS * M_V_DIM
IN_SIZES = (ATT_Q, ATT_KV, ATT_KV, M_QK, M_QK, M_V, M_V, M_HEADS, M_HEADS, D_MODEL, D_MODEL)
D_IN = ATT_Q + 2 * ATT_KV + 2 * M_QK + 2 * M_V + 2 * M_HEADS + 2 * D_MODEL

kernel_name = "hybrid_swa_mlstm_macaron_block"


def rmsnorm(x, g):
    xf = x.astype(jnp.float32)
    y = xf * lax.rsqrt(jnp.mean(xf * xf, axis=-1, keepdims=True) + EPS)
    return (y * g.astype(jnp.float32)).astype(x.dtype)


def swiglu(x, wg, wu, wd):
    return (jax.nn.silu(x @ wg) * (x @ wu)) @ wd


def alibi_slopes(n):
    return jnp.exp2(-8.0 * jnp.arange(1, n + 1, dtype=jnp.float32) / n)


def split_columns(z):
    parts = []
    off = 0
    for size in IN_SIZES:
        parts.append(z[..., off:off + size])
        off += size
    return parts


def causal_depthwise_conv(x, w, b):
    S = x.shape[1]
    xp = jnp.pad(x, ((0, 0), (CONV_WIDTH - 1, 0), (0, 0)))
    y = xp[:, 0:S] * w[0]
    for j in range(1, CONV_WIDTH):
        y = y + xp[:, j:j + S] * w[j]
    return y + b


def sliding_window_attention(q, k, v, sinks):
    B, S = q.shape[0], q.shape[1]
    nb = S // ATT_BLOCK
    qb = q.reshape(B, nb, ATT_BLOCK, ATT_KV_HEADS, ATT_GROUP, ATT_HEAD_DIM)
    kb = k.reshape(B, nb, ATT_BLOCK, ATT_KV_HEADS, ATT_HEAD_DIM)
    vb = v.reshape(B, nb, ATT_BLOCK, ATT_KV_HEADS, ATT_HEAD_DIM)
    zpad = jnp.zeros_like(kb[:, :1])
    kk = jnp.concatenate([jnp.concatenate([zpad, kb[:, :-1]], axis=1), kb], axis=2)
    vv = jnp.concatenate([jnp.concatenate([zpad, vb[:, :-1]], axis=1), vb], axis=2)
    scale = 1.0 / math.sqrt(ATT_HEAD_DIM)
    s = jnp.einsum('bnqhgd,bnkhd->bnhgqk', qb, kk).astype(jnp.float32) * scale
    qi = jnp.arange(ATT_BLOCK)[:, None]
    kj = jnp.arange(2 * ATT_BLOCK)[None, :]
    dist = qi - kj + ATT_BLOCK
    blk = jnp.arange(nb)[:, None, None]
    valid = (dist >= 0) & (dist < WINDOW) & (blk * ATT_BLOCK + kj - ATT_BLOCK >= 0)
    slopes = alibi_slopes(ATT_HEADS).reshape(ATT_KV_HEADS, ATT_GROUP)
    s = s - slopes[None, None, :, :, None, None] * dist.astype(jnp.float32)[None, None, None, None]
    s = jnp.where(valid[None, :, None, None], s, -jnp.inf)
    sink = sinks.astype(jnp.float32).reshape(ATT_KV_HEADS, ATT_GROUP)[None, None, :, :, None, None]
    m = jnp.maximum(jnp.max(s, axis=-1, keepdims=True), sink)
    p = jnp.exp(s - m)
    p = p / (jnp.sum(p, axis=-1, keepdims=True) + jnp.exp(sink - m))
    o = jnp.einsum('bnhgqk,bnkhd->bnqhgd', p.astype(vv.dtype), vv)
    return o.reshape(B, S, ATT_Q)


def mlstm_chunkwise(q, k, v, i_pre, f_pre):
    B, S = q.shape[0], q.shape[1]
    nc = S // M_CHUNK
    L = M_CHUNK
    f32 = jnp.float32

    def chunks(t, d):
        return t.astype(f32).reshape(B, nc, L, M_HEADS, d).transpose(0, 3, 1, 2, 4)

    qc = chunks(q, M_QK_DIM)
    kc = chunks(k, M_QK_DIM) * (1.0 / math.sqrt(M_QK_DIM))
    vc = chunks(v, M_V_DIM)
    logi = i_pre.astype(f32).reshape(B, nc, L, M_HEADS).transpose(0, 3, 1, 2)
    logf = jax.nn.log_sigmoid(f_pre.astype(f32)).reshape(B, nc, L, M_HEADS).transpose(0, 3, 1, 2)
    b = jnp.cumsum(logf, axis=-1)
    b_last = b[..., -1]
    g = b_last[..., None] - b + logi

    def step(carry, xs):
        C, n, m = carry
        bl, gs, ks, vs = xs
        m_new = jnp.maximum(bl + m, jnp.max(gs, axis=-1))
        decay = jnp.exp(bl + m - m_new)
        w = jnp.exp(gs - m_new[..., None])
        C_new = decay[..., None, None] * C + jnp.einsum('bhl,bhlk,bhlv->bhkv', w, ks, vs)
        n_new = decay[..., None] * n + jnp.einsum('bhl,bhlk->bhk', w, ks)
        return (C_new, n_new, m_new), (C, n, m)

    init = (jnp.zeros((B, M_HEADS, M_QK_DIM, M_V_DIM), f32),
            jnp.zeros((B, M_HEADS, M_QK_DIM), f32),
            jnp.zeros((B, M_HEADS), f32))
    xs = (jnp.moveaxis(b_last, 2, 0), jnp.moveaxis(g, 2, 0), jnp.moveaxis(kc, 2, 0), jnp.moveaxis(vc, 2, 0))
    _, (C_in, n_in, m_in) = lax.scan(step, init, xs)
    C_in = jnp.moveaxis(C_in, 0, 2)
    n_in = jnp.moveaxis(n_in, 0, 2)
    m_in = jnp.moveaxis(m_in, 0, 2)

    a = b + m_in[..., None]
    D = b[..., :, None] - b[..., None, :] + logi[..., None, :]
    causal = jnp.tril(jnp.ones((L, L), dtype=bool))
    D = jnp.where(causal, D, -jnp.inf)
    m_t = jnp.maximum(a, jnp.max(D, axis=-1))
    inter_w = jnp.exp(a - m_t)
    P = jnp.einsum('bhcld,bhcsd->bhcls', qc, kc) * jnp.exp(D - m_t[..., None])
    num = jnp.einsum('bhcls,bhcsv->bhclv', P, vc) + inter_w[..., None] * jnp.einsum('bhcld,bhcdv->bhclv', qc, C_in)
    den = jnp.sum(P, axis=-1) + inter_w * jnp.einsum('bhcld,bhcd->bhcl', qc, n_in)
    h = num / jnp.maximum(jnp.abs(den), jnp.exp(-m_t))[..., None]
    return h.transpose(0, 2, 3, 1, 4).reshape(B, S, M_HEADS, M_V_DIM).astype(q.dtype)


def hybrid_mixer(u, w_in, conv_w, conv_b, attn_sinks, m_igate_b, m_fgate_b, m_head_g, w_attn_up, w_mlstm_up, w_out):
    B, S = u.shape[0], u.shape[1]
    aq, ak, av, mq, mk, mv, mo, mi, mf, ga, gm = split_columns(u @ w_in)
    att = sliding_window_attention(aq.reshape(B, S, ATT_HEADS, ATT_HEAD_DIM),
                                   ak.reshape(B, S, ATT_KV_HEADS, ATT_HEAD_DIM),
                                   av.reshape(B, S, ATT_KV_HEADS, ATT_HEAD_DIM), attn_sinks)
    qk = jax.nn.silu(causal_depthwise_conv(jnp.concatenate([mq, mk], axis=-1), conv_w, conv_b))
    h = mlstm_chunkwise(qk[..., :M_QK].reshape(B, S, M_HEADS, M_QK_DIM),
                        qk[..., M_QK:].reshape(B, S, M_HEADS, M_QK_DIM),
                        mv.reshape(B, S, M_HEADS, M_V_DIM), mi + m_igate_b, mf + m_fgate_b)
    h = rmsnorm(h, m_head_g.reshape(M_HEADS, M_V_DIM)).reshape(B, S, M_V)
    h = jax.nn.sigmoid(mo) * h
    y = jax.nn.sigmoid(ga) * (att @ w_attn_up) + jax.nn.sigmoid(gm) * (h @ w_mlstm_up)
    return y @ w_out


def setup_inputs(seed: int = 0) -> dict:
    key = jax.random.key(seed)
    ks = jax.random.split(key, 24)
    Ld = DEPTH

    def nrm(k, shape, scale):
        return jax.random.normal(k, shape, jnp.float32) * scale

    def gain(k, n):
        return 1.0 + 0.02 * jax.random.normal(k, (Ld, n), jnp.float32)

    dsc = D_MODEL ** -0.5
    fsc = D_FF ** -0.5
    return {
        "x": nrm(ks[0], (BATCH, SEQ, D_MODEL), 1.0),
        "ffn1_pre_g": gain(ks[1], D_MODEL),
        "ffn1_wg": nrm(ks[2], (Ld, D_MODEL, D_FF), dsc),
        "ffn1_wu": nrm(ks[3], (Ld, D_MODEL, D_FF), dsc),
        "ffn1_wd": nrm(ks[4], (Ld, D_FF, D_MODEL), fsc),
        "ffn1_post_g": gain(ks[5], D_MODEL),
        "mix_pre_g": gain(ks[6], D_MODEL),
        "w_in": nrm(ks[7], (Ld, D_MODEL, D_IN), dsc),
        "conv_w": nrm(ks[8], (Ld, CONV_WIDTH, 2 * M_QK), CONV_WIDTH ** -0.5),
        "conv_b": nrm(ks[9], (Ld, 2 * M_QK), 0.02),
        "attn_sinks": nrm(ks[10], (Ld, ATT_HEADS), 0.5),
        "m_igate_b": nrm(ks[11], (Ld, M_HEADS), 0.1),
        "m_fgate_b": jnp.linspace(3.0, 6.0, M_HEADS, dtype=jnp.float32)[None, :] + nrm(ks[12], (Ld, M_HEADS), 0.1),
        "m_head_g": gain(ks[13], M_V),
        "w_attn_up": nrm(ks[14], (Ld, ATT_Q, D_MODEL), ATT_Q ** -0.5),
        "w_mlstm_up": nrm(ks[15], (Ld, M_V, D_MODEL), M_V ** -0.5),
        "w_out": nrm(ks[16], (Ld, D_MODEL, D_MODEL), dsc),
        "mix_post_g": gain(ks[17], D_MODEL),
        "ffn2_pre_g": gain(ks[18], D_MODEL),
        "ffn2_wg": nrm(ks[19], (Ld, D_MODEL, D_FF), dsc),
        "ffn2_wu": nrm(ks[20], (Ld, D_MODEL, D_FF), dsc),
        "ffn2_wd": nrm(ks[21], (Ld, D_FF, D_MODEL), fsc),
        "ffn2_post_g": gain(ks[22], D_MODEL),
    }


def reference(x, ffn1_pre_g, ffn1_wg, ffn1_wu, ffn1_wd, ffn1_post_g, mix_pre_g, w_in, conv_w, conv_b,
              attn_sinks, m_igate_b, m_fgate_b, m_head_g, w_attn_up, w_mlstm_up, w_out, mix_post_g,
              ffn2_pre_g, ffn2_wg, ffn2_wu, ffn2_wd, ffn2_post_g):
    h = x
    for l in range(DEPTH):
        f = swiglu(rmsnorm(h, ffn1_pre_g[l]), ffn1_wg[l], ffn1_wu[l], ffn1_wd[l])
        h = h + 0.5 * rmsnorm(f, ffn1_post_g[l])
        y = hybrid_mixer(rmsnorm(h, mix_pre_g[l]), w_in[l], conv_w[l], conv_b[l], attn_sinks[l],
                         m_igate_b[l], m_fgate_b[l], m_head_g[l], w_attn_up[l], w_mlstm_up[l], w_out[l])
        h = h + rmsnorm(y, mix_post_g[l])
        f = swiglu(rmsnorm(h, ffn2_pre_g[l]), ffn2_wg[l], ffn2_wu[l], ffn2_wd[l])
        h = h + 0.5 * rmsnorm(f, ffn2_post_g[l])
    return h
```

```cpp
#include <hip/hip_runtime.h>
#include <hip/hip_cooperative_groups.h>
#include <cstdio>
#include <cstdint>
namespace cg = cooperative_groups;
namespace pg8 {
#define PG8_LAS __attribute__((address_space(3)))
typedef unsigned short bf16_t;
typedef short bf16x8 __attribute__((ext_vector_type(8)));
typedef float f32x4 __attribute__((ext_vector_type(4)));
typedef unsigned u32x4 __attribute__((ext_vector_type(4)));
constexpr int BM = 256, BK = 64, HALF = 128, HTB = HALF * BK * 2  , STAGE_BYTES = 8 * HTB, NXCD = 8, WGM = 8;

__host__ __device__ __forceinline__ int lds_byte(int r, int c) { const int st = (r >> 4) * 2 + (c >> 5), rr = r & 15, cc = c & 31, ob = rr * 64 + cc * 2; return st * 1024 + (ob ^ (((ob >> 9) & 1) << 5)); }
__host__ __device__ __forceinline__ void stage_rc(int b, int& R, int& C) { const int st = b / 1024, sb = b % 1024, swz = sb ^ (((sb >> 9) & 1) << 5); R = (st >> 1) * 16 + swz / 64; C = (st & 1) * 32 + (swz % 64) / 2; }
__host__ __device__ __forceinline__ int perm32(int rho) { const int n = rho >> 4, i = rho & 15; return 8 * (i >> 2) + 4 * n + (i & 3); }

struct Unit { int pm, pn; };
struct Gemm { const bf16_t* A; const bf16_t* Bt; int M, N, K; };

struct StaticOrder {
    int nM, nN, nwg, G, c;
    __host__ __device__ void init(int M, int N, int G_, int c_) { nM = M / BM; nN = N / BM; nwg = nM * nN; G = G_; c = c_; }
    __host__ __device__ bool next(int i, Unit& u) const {
        const long L = (long)i * G + c; if (L >= nwg) return false;
        int wgid = (int)L; { const int q = nwg / NXCD, r = nwg % NXCD, xcd = wgid % NXCD, off = wgid / NXCD; wgid = (xcd < r ? xcd * (q + 1) : r * (q + 1) + (xcd - r) * q) + off; }
        const int nig = WGM * nN, gid = wgid / nig, fm = gid * WGM, gsz = (nM - fm) < WGM ? (nM - fm) : WGM;
        u.pm = fm + ((wgid % nig) % gsz); u.pn = (wgid % nig) / gsz; return true;
    }
    __device__ __forceinline__ void a_ready(const Unit&) const {}
    __device__ __forceinline__ void done(const Unit&) const {}
};

__device__ __forceinline__ unsigned cvt_pk_bf16(float lo, float hi) { unsigned r; asm volatile("v_cvt_pk_bf16_f32 %0, %1, %2" : "=v"(r) : "v"(lo), "v"(hi)); return r; }
template <int PAIR> struct GenSched {
    StaticOrder so; static constexpr int pair = PAIR;
    __device__ __forceinline__ bool next(int i, Unit& u) const {
        if (pair) { Unit t; if (!so.next(i >> 1, t)) return false; const int part = i & 1; u.pm = t.pm + part * 64; u.pn = t.pn + part * 8; return true; }
        return so.next(i, u);
    }
    __device__ __forceinline__ void a_ready(const Unit&) const {}
    __device__ __forceinline__ void done(const Unit&) const {}
};
__device__ __forceinline__ float bflo(unsigned w) { return __builtin_bit_cast(float, w << 16); }
__device__ __forceinline__ float bfhi(unsigned w) { return __builtin_bit_cast(float, w & 0xffff0000u); }
__device__ __forceinline__ float sigm(float x) { return __builtin_amdgcn_rcpf(1.0f + __builtin_amdgcn_exp2f(x * -1.44269504089f)); }
template <int MODE> struct GenEpi {
    static constexpr bool PERM = true, AFTER_DRAIN = false; static constexpr int mode = MODE;
    bf16_t* O; int ldc; bf16_t* O2; const bf16_t* Gt;
    __device__ __forceinline__ void operator()(const f32x4 (&acc)[2][2][4][2], const Unit& u, int wr, int wc, int fr, int fq) const {
        if constexpr (MODE == 1) {
            const int row0 = u.pm * BM + wr * 64 + fr, col0 = u.pn * 128 + wc * 32 + 8 * fq;
#pragma unroll
            for (int ai = 0; ai < 2; ++ai)
#pragma unroll
                for (int m = 0; m < 4; ++m) { bf16_t* rowp = O + (size_t)(row0 + ai * HALF + m * 16) * ldc + col0;
                    f32x4 g0 = acc[ai][0][m][0], g1 = acc[ai][0][m][1], u0 = acc[ai][1][m][0], u1 = acc[ai][1][m][1], h0, h1;
#pragma unroll
                    for (int j = 0; j < 4; ++j) { h0[j] = g0[j] * u0[j] * sigm(g0[j]); h1[j] = g1[j] * u1[j] * sigm(g1[j]); }
                    u32x4 w; w.x = cvt_pk_bf16(h0[0], h0[1]); w.y = cvt_pk_bf16(h0[2], h0[3]); w.z = cvt_pk_bf16(h1[0], h1[1]); w.w = cvt_pk_bf16(h1[2], h1[3]);
                    *(u32x4*)rowp = w; }
        } else if constexpr (MODE == 3) {
            const int part = u.pn >> 3, pn = u.pn & 7, pm = u.pm & 63;
            const int row0 = pm * BM + wr * 64 + fr, col0 = pn * BM + wc * 32 + 8 * fq;
#pragma unroll
            for (int ai = 0; ai < 2; ++ai)
#pragma unroll
                for (int m = 0; m < 4; ++m) { const size_t row = (size_t)(row0 + ai * HALF + m * 16);
#pragma unroll
                    for (int bj = 0; bj < 2; ++bj) { const int col = col0 + bj * HALF;
                        const u32x4 gt = *(const u32x4*)(Gt + row * 4096 + part * 2048 + col);
                        const f32x4 v0 = acc[ai][bj][m][0], v1 = acc[ai][bj][m][1];
                        float r[8];
                        r[0] = v0[0] * sigm(bflo(gt.x)); r[1] = v0[1] * sigm(bfhi(gt.x)); r[2] = v0[2] * sigm(bflo(gt.y)); r[3] = v0[3] * sigm(bfhi(gt.y));
                        r[4] = v1[0] * sigm(bflo(gt.z)); r[5] = v1[1] * sigm(bfhi(gt.z)); r[6] = v1[2] * sigm(bflo(gt.w)); r[7] = v1[3] * sigm(bfhi(gt.w));
                        bf16_t* yp = O + row * 2048 + col;
                        if (part) { const u32x4 yo = *(const u32x4*)yp;
                            r[0] += bflo(yo.x); r[1] += bfhi(yo.x); r[2] += bflo(yo.y); r[3] += bfhi(yo.y); r[4] += bflo(yo.z); r[5] += bfhi(yo.z); r[6] += bflo(yo.w); r[7] += bfhi(yo.w); }
                        u32x4 w; w.x = cvt_pk_bf16(r[0], r[1]); w.y = cvt_pk_bf16(r[2], r[3]); w.z = cvt_pk_bf16(r[4], r[5]); w.w = cvt_pk_bf16(r[6], r[7]);
                        *(u32x4*)yp = w; } }
        } else {
            int colt = u.pn * BM; bf16_t* base = O; int ld = ldc;
            if (mode == 2 && colt >= 4608) { base = O2; ld = 4096; colt -= 4608; }
            const int row0 = u.pm * BM + wr * 64 + fr, col0 = colt + wc * 32 + 8 * fq;
#pragma unroll
            for (int ai = 0; ai < 2; ++ai)
#pragma unroll
                for (int m = 0; m < 4; ++m) { bf16_t* rowp = base + (size_t)(row0 + ai * HALF + m * 16) * ld + col0;
#pragma unroll
                    for (int bj = 0; bj < 2; ++bj) { const f32x4 v0 = acc[ai][bj][m][0], v1 = acc[ai][bj][m][1];
                        u32x4 w; w.x = cvt_pk_bf16(v0[0], v0[1]); w.y = cvt_pk_bf16(v0[2], v0[3]); w.z = cvt_pk_bf16(v1[0], v1[1]); w.w = cvt_pk_bf16(v1[2], v1[3]);
                        *(u32x4*)(rowp + bj * HALF) = w; } }
        }
    }
};

template <class Epi, class Sched, bool ALIGN_EPI = false, bool SP2 = false>
__device__ __forceinline__ void gemm_phase(PG8_LAS unsigned char* lds, const Gemm g, const Sched& S, const Epi& E) {
    const int tid = threadIdx.x, wid = __builtin_amdgcn_readfirstlane(tid >> 6), lane = tid & 63, wr = wid >> 2, wc = wid & 3, fr = lane & 15, fq = lane >> 4;
    const int K = g.K, nt = K / BK;
    unsigned voffA[2], voffB[2];
#pragma unroll
    for (int i = 0; i < 2; ++i) { int R, C; stage_rc(tid * 16 + i * 8192, R, C); const int Rb = Epi::PERM ? ((R & ~31) + perm32(R & 31)) : R;
        voffA[i] = (unsigned)(R * K + C) * 2u; voffB[i] = (unsigned)(Rb * K + C) * 2u; }
    const size_t kstep = (size_t)(BK * 2);
    const size_t hstep = (size_t)HALF * K * 2;
    const size_t tstep = 2 * hstep;
    const unsigned ldsw = (unsigned)wid * 1024u;
    const int aoff = lds_byte(wr * 64 + fr, fq * 8), boff = lds_byte(wc * 32 + fr, fq * 8);
#define PG8_SA(b, h) (((b) * 2 + (h)) * HTB)
#define PG8_SB(b, h) ((4 + (b) * 2 + (h)) * HTB)
#define PG8_STAGE(bufoff, gbase, voff) do { _Pragma("unroll") for (int _i = 0; _i < 2; ++_i) \
        __builtin_amdgcn_global_load_lds((const unsigned*)((const char*)(gbase) + (voff)[_i]), (PG8_LAS unsigned*)(lds + (bufoff) + ldsw + _i * 8192), 16, 0, 0); } while (0)
#define PG8_LDA(dst, b, h) do { _Pragma("unroll") for (int m = 0; m < 4; ++m) _Pragma("unroll") for (int k = 0; k < 2; ++k) dst[m][k] = *(const PG8_LAS bf16x8*)(lds + PG8_SA(b, h) + aoff + m * 2048 + k * 1024); } while (0)
#define PG8_LDB(dst, b, h) do { _Pragma("unroll") for (int n = 0; n < 2; ++n) _Pragma("unroll") for (int k = 0; k < 2; ++k) dst[n][k] = *(const PG8_LAS bf16x8*)(lds + PG8_SB(b, h) + boff + n * 2048 + k * 1024); } while (0)
#define PG8_MMA(ai, bj, At, Bt) do { __builtin_amdgcn_s_setprio(1); _Pragma("unroll") for (int m = 0; m < 4; ++m) _Pragma("unroll") for (int n = 0; n < 2; ++n) _Pragma("unroll") for (int k = 0; k < 2; ++k) \
        acc[ai][bj][m][n] = __builtin_amdgcn_mfma_f32_16x16x32_bf16(Bt[n][k], At[m][k], acc[ai][bj][m][n], 0, 0, 0); __builtin_amdgcn_s_setprio(0); } while (0)
#define PG8_WAIT_V(n) asm volatile("s_waitcnt vmcnt(" #n ")" ::: "memory")
#define PG8_WAIT_L(n) asm volatile("s_waitcnt lgkmcnt(" #n ")" ::: "memory")
#define PG8_BAR __builtin_amdgcn_s_barrier()
#define PG8_SCHED __builtin_amdgcn_sched_barrier(0)
    Unit cur, nxt; int ui = 0;
    if (!S.next(0, cur)) return;
    f32x4 acc[2][2][4][2];
#pragma unroll
    for (int a = 0; a < 2; ++a)
#pragma unroll
        for (int b = 0; b < 2; ++b)
#pragma unroll
            for (int m = 0; m < 4; ++m)
#pragma unroll
                for (int n = 0; n < 2; ++n) acc[a][b][m][n] = (f32x4){0.f, 0.f, 0.f, 0.f};
    bf16x8 At[4][2], B0[2][2], B1[2][2];
    const char* cA = (const char*)g.A + (size_t)cur.pm * tstep; const char* cB = (const char*)g.Bt + (size_t)cur.pn * tstep;
    S.a_ready(cur);
    if constexpr (SP2) {
        PG8_STAGE(PG8_SB(0, 0), cB, voffB); PG8_STAGE(PG8_SB(0, 1), cB + hstep, voffB); PG8_STAGE(PG8_SA(0, 0), cA, voffA); PG8_STAGE(PG8_SA(0, 1), cA + hstep, voffA);
        if (wr == 1) PG8_BAR;
        PG8_WAIT_V(2); PG8_BAR;
        PG8_STAGE(PG8_SB(1, 0), cB + kstep, voffB); PG8_STAGE(PG8_SA(1, 0), cA + kstep, voffA); PG8_STAGE(PG8_SB(1, 1), cB + hstep + kstep, voffB);
        PG8_WAIT_V(6); PG8_BAR;
    } else {
        PG8_STAGE(PG8_SB(0, 0), cB, voffB); PG8_STAGE(PG8_SA(0, 0), cA, voffA); PG8_STAGE(PG8_SB(0, 1), cB + hstep, voffB); PG8_STAGE(PG8_SA(0, 1), cA + hstep, voffA);
        if (wr == 1) PG8_BAR;
        PG8_WAIT_V(4); PG8_BAR;
        PG8_STAGE(PG8_SB(1, 0), cB + kstep, voffB); PG8_STAGE(PG8_SA(1, 0), cA + kstep, voffA); PG8_STAGE(PG8_SB(1, 1), cB + hstep + kstep, voffB);
        PG8_WAIT_V(6); PG8_BAR;
    }
    for (;;) {
        const bool has_next = S.next(ui + 1, nxt);
        const char* nA = has_next ? (const char*)g.A + (size_t)nxt.pm * tstep : cA; const char* nB = has_next ? (const char*)g.Bt + (size_t)nxt.pn * tstep : cB;
        for (int t = 0; t < nt; t += 2) {
            const bool last = (t == nt - 2);
            const char* a1 = cA + (size_t)(t + 1) * kstep;
            const char* a2 = last ? nA : cA + (size_t)(t + 2) * kstep; const char* b2 = last ? nB : cB + (size_t)(t + 2) * kstep;
            const char* a3 = a2 + kstep; const char* b3 = b2 + kstep;
            if (last && has_next) S.a_ready(nxt);
            if constexpr (SP2) {
            PG8_LDB(B0, 0, 0); PG8_LDB(B1, 0, 1); PG8_SCHED; PG8_LDA(At, 0, 0); PG8_STAGE(PG8_SA(1, 1), a1 + hstep, voffA);
            PG8_WAIT_V(8); PG8_WAIT_L(0); PG8_BAR; PG8_MMA(0, 0, At, B0); PG8_MMA(0, 1, At, B1); PG8_BAR; PG8_SCHED;
            PG8_LDA(At, 0, 1); PG8_STAGE(PG8_SB(0, 0), b2, voffB); PG8_STAGE(PG8_SB(0, 1), b2 + hstep, voffB); PG8_STAGE(PG8_SA(0, 0), a2, voffA);
            PG8_WAIT_V(8); PG8_WAIT_L(0); PG8_BAR; PG8_MMA(1, 0, At, B0); PG8_MMA(1, 1, At, B1); PG8_BAR; PG8_SCHED;
            PG8_LDB(B0, 1, 0); PG8_LDB(B1, 1, 1); PG8_SCHED; PG8_LDA(At, 1, 0); PG8_STAGE(PG8_SA(0, 1), a2 + hstep, voffA);
            PG8_WAIT_V(8); PG8_WAIT_L(0); PG8_BAR; PG8_MMA(0, 0, At, B0); PG8_MMA(0, 1, At, B1); PG8_BAR; PG8_SCHED;
            PG8_LDA(At, 1, 1); PG8_STAGE(PG8_SB(1, 0), b3, voffB); PG8_STAGE(PG8_SB(1, 1), b3 + hstep, voffB); PG8_STAGE(PG8_SA(1, 0), a3, voffA);
            PG8_WAIT_V(8); PG8_WAIT_L(0); PG8_BAR; PG8_MMA(1, 0, At, B0); PG8_MMA(1, 1, At, B1); PG8_BAR; PG8_SCHED;
            } else {
            PG8_LDB(B0, 0, 0); PG8_SCHED; PG8_LDA(At, 0, 0); PG8_STAGE(PG8_SA(1, 1), a1 + hstep, voffA);
            PG8_WAIT_L(8); PG8_BAR; PG8_WAIT_L(0); PG8_MMA(0, 0, At, B0); PG8_BAR; PG8_SCHED;
            PG8_LDB(B1, 0, 1); PG8_STAGE(PG8_SB(0, 0), b2, voffB);
            PG8_BAR; PG8_WAIT_L(0); PG8_MMA(0, 1, At, B1); PG8_BAR;
            PG8_LDA(At, 0, 1); PG8_STAGE(PG8_SA(0, 0), a2, voffA);
            PG8_BAR; PG8_WAIT_L(0); PG8_MMA(1, 0, At, B0); PG8_BAR; PG8_SCHED;
            PG8_STAGE(PG8_SB(0, 1), b2 + hstep, voffB);
            PG8_WAIT_V(6); PG8_BAR; PG8_MMA(1, 1, At, B1); PG8_BAR;
            PG8_LDB(B0, 1, 0); PG8_SCHED; PG8_LDA(At, 1, 0); PG8_STAGE(PG8_SA(0, 1), a2 + hstep, voffA);
            PG8_WAIT_L(8); PG8_BAR; PG8_WAIT_L(0); PG8_MMA(0, 0, At, B0); PG8_BAR; PG8_SCHED;
            PG8_LDB(B1, 1, 1); PG8_STAGE(PG8_SB(1, 0), b3, voffB);
            PG8_BAR; PG8_WAIT_L(0); PG8_MMA(0, 1, At, B1); PG8_BAR;
            PG8_LDA(At, 1, 1); PG8_STAGE(PG8_SA(1, 0), a3, voffA);
            PG8_BAR; PG8_WAIT_L(0); PG8_MMA(1, 0, At, B0); PG8_BAR; PG8_SCHED;
            PG8_STAGE(PG8_SB(1, 1), b3 + hstep, voffB);
            PG8_WAIT_V(6); PG8_BAR; PG8_MMA(1, 1, At, B1); PG8_BAR;
            }
        }
        if constexpr (ALIGN_EPI) { if (wr == 0) PG8_BAR; }
        if constexpr (!Epi::AFTER_DRAIN) { E(acc, cur, wr, wc, fr, fq); S.done(cur); }
        if (!has_next) break;
#pragma unroll
        for (int a = 0; a < 2; ++a)
#pragma unroll
            for (int b = 0; b < 2; ++b)
#pragma unroll
                for (int m = 0; m < 4; ++m)
#pragma unroll
                    for (int n = 0; n < 2; ++n) acc[a][b][m][n] = (f32x4){0.f, 0.f, 0.f, 0.f};
        cur = nxt; cA = nA; cB = nB; ++ui;
        if constexpr (ALIGN_EPI) { if (wr == 1) PG8_BAR; }
    }
    PG8_WAIT_V(0);
    if constexpr (!ALIGN_EPI) { if (wr == 0) PG8_BAR; }
    PG8_BAR;
    if constexpr (Epi::AFTER_DRAIN) { E.fused(acc, cur, wr, wc, fr, fq, lds, wid, lane); S.done(cur); }
#undef PG8_SA
#undef PG8_SB
#undef PG8_STAGE
#undef PG8_LDA
#undef PG8_LDB
#undef PG8_MMA
#undef PG8_WAIT_V
#undef PG8_WAIT_L
#undef PG8_BAR
#undef PG8_SCHED
}
}
#define GAS __attribute__((address_space(1)))
#define LAS __attribute__((address_space(3)))
typedef unsigned short bf16;
typedef unsigned v4u __attribute__((ext_vector_type(4)));
typedef float f32x4 __attribute__((ext_vector_type(4)));
typedef short bf16x8 __attribute__((ext_vector_type(8)));
typedef GAS unsigned gu32;
typedef GAS unsigned long long gu64;
#define RLX_AGENT __ATOMIC_RELAXED, __HIP_MEMORY_SCOPE_AGENT
#define LDS_WAIT() asm volatile("s_waitcnt lgkmcnt(0)" ::: "memory")
#define VM_WAIT() asm volatile("s_waitcnt vmcnt(0)" ::: "memory")
__device__ __forceinline__ unsigned long long rt() { return __builtin_amdgcn_s_memrealtime(); }
__device__ __forceinline__ unsigned f2bf(float f) { unsigned u = __builtin_bit_cast(unsigned, f); return (u + 0x7fffu + ((u >> 16) & 1u)) >> 16; }
__device__ __forceinline__ unsigned pk2(float lo, float hi) { return f2bf(lo) | (f2bf(hi) << 16); }

#define XB_TMO      128
#define XB_XCNT(j)  (256  + 64 * (j))
#define XB_XSUB(j)  (1280 + 64 * (j))
#define XB_XGEN(j)  (2304 + 64 * (j))
#define XB_TOP      3328
#define XB_TOPGEN   3392
#define XCD_BAR_WORDS 3456
#define XB_SPIN_CAP (1u << 18)

__device__ __forceinline__ unsigned xb_ld(unsigned* p)              { return __hip_atomic_load(p, __ATOMIC_RELAXED, __HIP_MEMORY_SCOPE_AGENT); }
__device__ __forceinline__ unsigned xb_add(unsigned* p, unsigned v) { return __hip_atomic_fetch_add(p, v, __ATOMIC_RELAXED, __HIP_MEMORY_SCOPE_AGENT); }
__device__ __forceinline__ unsigned xb_xcc_id() { return (unsigned)__builtin_amdgcn_s_getreg((3 << 11) | 20) & 0xFu; }
#define XB_SPIN(cond, bar) do { unsigned _sp = 0; while (cond) { __builtin_amdgcn_s_sleep(1); \
    if ((++_sp & 255u) == 0u) { if (xb_ld(&(bar)[XB_TMO])) break; if (_sp > XB_SPIN_CAP) { atomicAdd(&(bar)[XB_TMO], 1u); break; } } } } while (0)

struct XcdBarrier {
    unsigned* bar; unsigned x;
    volatile LAS unsigned* st;
};

__device__ __forceinline__ XcdBarrier xcd_barrier_post(unsigned* bar, volatile LAS unsigned* st) {
    XcdBarrier b; b.bar = bar; b.x = xb_xcc_id(); b.st = st;
    if (threadIdx.x == 0) (void)xb_add(&bar[XB_XCNT(b.x)], 1u);
    return b;
}
__device__ __forceinline__ void xcd_barrier_complete(unsigned* bar, unsigned x, unsigned& nloc, unsigned& nx) {
    const unsigned G = gridDim.x * gridDim.y * gridDim.z;
    unsigned sum, cnt, mine, sp = 0u;
    for (;;) {
        sum = 0u; cnt = 0u; mine = 0u;
#pragma unroll
        for (unsigned j = 0; j < 16; ++j) { const unsigned c = xb_ld(&bar[XB_XCNT(j)]); sum += c; cnt += (c > 0u) ? 1u : 0u; mine = (j == x) ? c : mine; }
        if (sum == G) break;
        __builtin_amdgcn_s_sleep(1);
        if ((++sp & 255u) == 0u) { if (xb_ld(&bar[XB_TMO])) break; if (sp > XB_SPIN_CAP) { atomicAdd(&bar[XB_TMO], 1u); break; } }
    }
    nloc = mine > 0u ? mine : 1u; nx = cnt > 0u ? cnt : 1u;
}

__device__ __forceinline__ void xcd_barrier(const XcdBarrier& b) {
    asm volatile("s_waitcnt vmcnt(0)" ::: "memory");
    __syncthreads();
    if (threadIdx.x == 0) {
        unsigned* bar = b.bar;
        __builtin_amdgcn_s_waitcnt(0);
        unsigned nloc = b.st[0], nx = b.st[1];
        if (nloc == 0u) { xcd_barrier_complete(bar, b.x, nloc, nx); b.st[0] = nloc; b.st[1] = nx; }
        const unsigned old = xb_add(&bar[XB_XSUB(b.x)], 1u);
        const unsigned gen = old / nloc;
        if (old + 1u == (gen + 1u) * nloc) {
            __builtin_amdgcn_fence(__ATOMIC_RELEASE, "agent");
            asm volatile("s_waitcnt vmcnt(0)" ::: "memory");
            const unsigned og = xb_add(&bar[XB_TOP], 1u);
            const unsigned tg = og / nx;
            if (og + 1u == (tg + 1u) * nx) xb_add(&bar[XB_TOPGEN], 1u);
            else XB_SPIN(xb_ld(&bar[XB_TOPGEN]) == tg, bar);
            __builtin_amdgcn_fence(__ATOMIC_ACQUIRE, "agent");
            xb_add(&bar[XB_XGEN(b.x)], 1u);
            asm volatile("s_waitcnt vmcnt(0)" ::: "memory");
        } else {
            XB_SPIN(xb_ld(&bar[XB_XGEN(b.x)]) == gen, bar);
            __builtin_amdgcn_fence(__ATOMIC_ACQUIRE, "agent");
            asm volatile("s_waitcnt vmcnt(0)" ::: "memory");
        }
    }
    __syncthreads();
}

constexpr int NWAVES = 8;
constexpr int M = 16384, D = 2048, FF = 5632, SEQ = 2048;
constexpr int NZ1 = 4608, NZ2 = 4096, NZ = 8704, DIN = 8712;
constexpr float EPS = 1e-6f;
constexpr size_t MiB = 1u << 20;
constexpr size_t WS_CTL = 0, CTL_ZERO_BYTES = 64 * 1024;
constexpr size_t WS_G = 1 * MiB;
constexpr size_t WS_SS = 2 * MiB;
constexpr size_t WS_WIN = 4 * MiB;
constexpr size_t WS_WUP = WS_WIN + (size_t)NZ * D * 2;
constexpr size_t WS_WOUT = WS_WUP + (size_t)4096 * 1024 * 2;
constexpr size_t WS_F2GU = WS_WOUT + (size_t)D * D * 2;
constexpr size_t WS_F2D = WS_F2GU + (size_t)2 * FF * D * 2;
constexpr size_t WS_WEND = WS_F2D + (size_t)D * FF * 2;
constexpr size_t WS_XA = 120 * MiB;
constexpr size_t WS_B = 184 * MiB;
constexpr size_t WS_H = WS_B, WS_F = WS_B + 176 * MiB, WS_Z1 = WS_B, WS_Z2 = WS_B + 144 * MiB, WS_Y = WS_B, WS_YO = WS_B + 144 * MiB;
constexpr size_t WS_END = WS_B + 272 * MiB;
static_assert(WS_WEND <= WS_XA, "weights fit");
static_assert(WS_END <= 512 * MiB, "workspace fits 512 MiB");
constexpr size_t OUT_F1GU = 0, OUT_F1D = (size_t)2 * FF * D * 2;
constexpr int LDS_BYTES = 147456;
constexpr int MISC_OFF = 131072 + 320;

typedef unsigned u32x2 __attribute__((ext_vector_type(2)));
__device__ __forceinline__ float bflo(unsigned w) { return __builtin_bit_cast(float, w << 16); }
__device__ __forceinline__ float bfhi(unsigned w) { return __builtin_bit_cast(float, w & 0xffff0000u); }
__device__ __forceinline__ unsigned cvtpk(float lo, float hi) { unsigned r; asm volatile("v_cvt_pk_bf16_f32 %0, %1, %2" : "=v"(r) : "v"(lo), "v"(hi)); return r; }
__device__ __forceinline__ float sigmf(float x) { return __builtin_amdgcn_rcpf(1.0f + __builtin_amdgcn_exp2f(x * -1.44269504089f)); }
__device__ __forceinline__ float wave_sum(float v) {
#pragma unroll
    for (int o = 1; o < 64; o <<= 1) v += __shfl_xor(v, o);
    return v;
}
__device__ __forceinline__ f32x4 mfma16(bf16x8 a, bf16x8 b, f32x4 c) { return __builtin_amdgcn_mfma_f32_16x16x32_bf16(a, b, c, 0, 0, 0); }

__device__ __forceinline__ void p0_transpose_item(const float* W, int ldw, int c0, int K, int k0, bf16* WT, int drow0, LAS float* scr, int lane) {
#pragma unroll 8
    for (int i = 0; i < 32; ++i) { const int kk = 2 * i + (lane >> 5); scr[kk * 33 + (lane & 31)] = W[(size_t)(k0 + kk) * ldw + c0 + (lane & 31)]; }
    LDS_WAIT(); asm volatile("" ::: "memory");
    const int c = lane & 7;
#pragma unroll
    for (int j = 0; j < 4; ++j) { const int n = (lane >> 3) + 8 * j; const LAS float* s = scr + (8 * c) * 33 + n;
        v4u o; o.x = cvtpk(s[0 * 33], s[1 * 33]); o.y = cvtpk(s[2 * 33], s[3 * 33]); o.z = cvtpk(s[4 * 33], s[5 * 33]); o.w = cvtpk(s[6 * 33], s[7 * 33]);
        *(GAS v4u*)(WT + (size_t)(drow0 + n) * K + k0 + 8 * c) = o; }
    LDS_WAIT(); asm volatile("" ::: "memory");
}
struct P0Ptrs { const float *f1g, *f1u, *f1d, *win, *wa, *wm, *wo, *f2g, *f2u, *f2d; bf16 *F1GU, *F1D, *WIN, *WUP, *WOUT, *F2GU, *F2D; };
__device__ __forceinline__ void p0_weights(const P0Ptrs& P, LAS unsigned char* lds, int gw, int NGW, int wave, int lane) {
    LAS float* scr = (LAS float*)(lds + wave * 16384);
    constexpr int I_GU = 32 * 176, I_D = 88 * 64, I_IN1 = 32 * 144, I_IN2 = 32 * 128, I_UP = 16 * 64, I_O = 32 * 64;
    constexpr int NITEMS = 2 * (2 * I_GU + I_D) + I_IN1 + I_IN2 + 2 * I_UP + I_O;
    for (int it = gw; it < NITEMS; it += NGW) {
        int r = it; const float* W; int ldw, c0, K, k0, drow0; bf16* WT;
        if (r < 2 * I_GU) { const int up = r >= I_GU; if (up) r -= I_GU; const int kb = r / 176, nb = r % 176; W = up ? P.f1u : P.f1g; ldw = FF; c0 = 32 * nb; K = D; k0 = 64 * kb; WT = P.F1GU; drow0 = 256 * (nb >> 2) + 32 * (nb & 3) + (up ? 128 : 0); }
        else if ((r -= 2 * I_GU) < I_D) { const int kb = r / 64, nb = r % 64; W = P.f1d; ldw = D; c0 = 32 * nb; K = FF; k0 = 64 * kb; WT = P.F1D; drow0 = 32 * nb; }
        else if ((r -= I_D) < 2 * I_GU) { const int up = r >= I_GU; if (up) r -= I_GU; const int kb = r / 176, nb = r % 176; W = up ? P.f2u : P.f2g; ldw = FF; c0 = 32 * nb; K = D; k0 = 64 * kb; WT = P.F2GU; drow0 = 256 * (nb >> 2) + 32 * (nb & 3) + (up ? 128 : 0); }
        else if ((r -= 2 * I_GU) < I_D) { const int kb = r / 64, nb = r % 64; W = P.f2d; ldw = D; c0 = 32 * nb; K = FF; k0 = 64 * kb; WT = P.F2D; drow0 = 32 * nb; }
        else if ((r -= I_D) < I_IN1) { const int kb = r / 144, nb = r % 144; W = P.win; ldw = DIN; c0 = 32 * nb; K = D; k0 = 64 * kb; WT = P.WIN; drow0 = 32 * nb; }
        else if ((r -= I_IN1) < I_IN2) { const int kb = r / 128, nb = r % 128; W = P.win; ldw = DIN; c0 = 4616 + 32 * nb; K = D; k0 = 64 * kb; WT = P.WIN; drow0 = 4608 + 32 * nb; }
        else if ((r -= I_IN2) < 2 * I_UP) { const int m2 = r >= I_UP; if (m2) r -= I_UP; const int kb = r / 64, nb = r % 64; W = m2 ? P.wm : P.wa; ldw = D; c0 = 32 * nb; K = 1024; k0 = 64 * kb; WT = P.WUP; drow0 = (m2 ? 2048 : 0) + 32 * nb; }
        else { r -= 2 * I_UP; const int kb = r / 64, nb = r % 64; W = P.wo; ldw = D; c0 = 32 * nb; K = D; k0 = 64 * kb; WT = P.WOUT; drow0 = 32 * nb; }
        p0_transpose_item(W, ldw, c0, K, k0, WT, drow0, scr, lane);
    }
}
__device__ __forceinline__ void p0_xn(const float* x, const float* gvec, bf16* XN, int gw, int NGW, int lane) {
    for (int m = gw; m < M; m += NGW) {
        const f32x4* xr = (const f32x4*)(x + (size_t)m * D) + lane; f32x4 v[8]; float s = 0.f;
#pragma unroll
        for (int j = 0; j < 8; ++j) { v[j] = xr[64 * j]; s += (v[j].x * v[j].x + v[j].y * v[j].y) + (v[j].z * v[j].z + v[j].w * v[j].w); }
        const float rstd = rsqrtf(wave_sum(s) * (1.f / D) + EPS);
        u32x2* o = (u32x2*)(XN + (size_t)m * D) + lane;
#pragma unroll
        for (int j = 0; j < 8; ++j) { const f32x4 gg = ((const f32x4*)gvec)[64 * j + lane]; u32x2 w; w.x = cvtpk(v[j].x * rstd * gg.x, v[j].y * rstd * gg.y); w.y = cvtpk(v[j].z * rstd * gg.z, v[j].w * rstd * gg.w); o[64 * j] = w; }
    }
}

template <bool HAS_NEXT, bool GATES>
__device__ __forceinline__ void row_phase(const bf16* src, const float* resid, float* outf, float scale, const float* g_post, const float* g_next, bf16* dst,
                                          const float* win, float* G, LAS unsigned char* lds, int gw, int NGW, int tid, int lane) {
    if (GATES) {
        for (int idx = tid; idx < 4096; idx += NWAVES * 64) { const int k = idx >> 1, hf = idx & 1; const f32x4 v = *(const f32x4*)(win + (size_t)k * DIN + 4608 + hf * 4);
            *(LAS f32x4*)(lds + k * 32 + (k >> 2) * 16 + hf * 16) = v; }
        __syncthreads();
    }
    for (int m = gw; m < M; m += NGW) {
        const u32x2* sr = (const u32x2*)(src + (size_t)m * D) + lane; float f[8][4]; float s = 0.f;
#pragma unroll
        for (int j = 0; j < 8; ++j) { const u32x2 w = sr[64 * j]; f[j][0] = bflo(w.x); f[j][1] = bfhi(w.x); f[j][2] = bflo(w.y); f[j][3] = bfhi(w.y);
            s += (f[j][0] * f[j][0] + f[j][1] * f[j][1]) + (f[j][2] * f[j][2] + f[j][3] * f[j][3]); }
        const float rstd = rsqrtf(wave_sum(s) * (1.f / D) + EPS) * scale;
        const f32x4* rr = (const f32x4*)(resid + (size_t)m * D) + lane; f32x4* oo = (f32x4*)(outf + (size_t)m * D) + lane; float s2 = 0.f;
#pragma unroll
        for (int j = 0; j < 8; ++j) { const f32x4 r = rr[64 * j]; const f32x4 gg = ((const f32x4*)g_post)[64 * j + lane];
            f[j][0] = r.x + f[j][0] * rstd * gg.x; f[j][1] = r.y + f[j][1] * rstd * gg.y; f[j][2] = r.z + f[j][2] * rstd * gg.z; f[j][3] = r.w + f[j][3] * rstd * gg.w;
            oo[64 * j] = (f32x4){f[j][0], f[j][1], f[j][2], f[j][3]};
            s2 += (f[j][0] * f[j][0] + f[j][1] * f[j][1]) + (f[j][2] * f[j][2] + f[j][3] * f[j][3]); }
        if (HAS_NEXT) {
            const float rstd2 = rsqrtf(wave_sum(s2) * (1.f / D) + EPS);
            u32x2* o = (u32x2*)(dst + (size_t)m * D) + lane;
#pragma unroll
            for (int j = 0; j < 8; ++j) { const f32x4 gg = ((const f32x4*)g_next)[64 * j + lane];
                f[j][0] *= rstd2 * gg.x; f[j][1] *= rstd2 * gg.y; f[j][2] *= rstd2 * gg.z; f[j][3] *= rstd2 * gg.w;
                u32x2 w; w.x = cvtpk(f[j][0], f[j][1]); w.y = cvtpk(f[j][2], f[j][3]); o[64 * j] = w; }
            if (GATES) {
                float ga[8];
#pragma unroll
                for (int c = 0; c < 8; ++c) ga[c] = 0.f;
#pragma unroll
                for (int j = 0; j < 8; ++j)
#pragma unroll
                    for (int e = 0; e < 4; ++e) { const LAS unsigned char* p = lds + 9216 * j + 144 * lane + 32 * e; const f32x4 w0 = *(const LAS f32x4*)p, w1 = *(const LAS f32x4*)(p + 16); const float uu = f[j][e];
                        ga[0] += uu * w0.x; ga[1] += uu * w0.y; ga[2] += uu * w0.z; ga[3] += uu * w0.w; ga[4] += uu * w1.x; ga[5] += uu * w1.y; ga[6] += uu * w1.z; ga[7] += uu * w1.w; }
#pragma unroll
                for (int c = 0; c < 8; ++c) ga[c] = wave_sum(ga[c]);
                if (lane == 0) { *(f32x4*)(G + (size_t)m * 8) = (f32x4){ga[0], ga[1], ga[2], ga[3]}; *(f32x4*)(G + (size_t)m * 8 + 4) = (f32x4){ga[4], ga[5], ga[6], ga[7]}; }
            }
        }
    }
}

constexpr int ATT_KS = 0, ATT_KROW = 144, ATT_VT = 39168, ATT_VROW = 560;
__device__ __forceinline__ void attn_unit(LAS unsigned char* lds, const bf16* Z1, bf16* ATT, const float* sinks, int unit, int tid) {
    const int lane = tid & 63, w = tid >> 6, l15 = lane & 15, g = lane >> 4;
    const int b = unit >> 6, qb = (unit >> 2) & 15, kvh = unit & 3;
    LAS unsigned char* Ks = lds + ATT_KS; LAS unsigned char* Vt = lds + ATT_VT;
    const size_t tok0 = (size_t)b * SEQ + qb * 128;
#pragma unroll
    for (int i = 0; i < 4; ++i) { const int id = tid + 512 * i, key = id >> 3, part = id & 7;
        v4u kv = (v4u){0u, 0u, 0u, 0u}, vv = (v4u){0u, 0u, 0u, 0u};
        if (qb > 0 || key >= 128) { const bf16* rowp = Z1 + (tok0 + key - 128) * NZ1; kv = *(const v4u*)(rowp + 1024 + kvh * 64 + part * 8); vv = *(const v4u*)(rowp + 1280 + kvh * 64 + part * 8); }
        *(LAS v4u*)(Ks + key * ATT_KROW + part * 16) = kv;
        LAS unsigned short* vt = (LAS unsigned short*)(Vt + (part * 8) * ATT_VROW + key * 2);
        vt[0 * 280] = (unsigned short)(vv.x & 0xffffu); vt[1 * 280] = (unsigned short)(vv.x >> 16); vt[2 * 280] = (unsigned short)(vv.y & 0xffffu); vt[3 * 280] = (unsigned short)(vv.y >> 16);
        vt[4 * 280] = (unsigned short)(vv.z & 0xffffu); vt[5 * 280] = (unsigned short)(vv.z >> 16); vt[6 * 280] = (unsigned short)(vv.w & 0xffffu); vt[7 * 280] = (unsigned short)(vv.w >> 16); }
    if (tid < 128) { const int key = 256 + (tid >> 3), part = tid & 7; *(LAS v4u*)(Ks + key * ATT_KROW + part * 16) = (v4u){0u, 0u, 0u, 0u}; }
    else if (tid < 256) { const int t2 = tid - 128, d = t2 >> 1, hf = t2 & 1; *(LAS v4u*)(Vt + d * ATT_VROW + 512 + hf * 16) = (v4u){0u, 0u, 0u, 0u}; }
    __syncthreads();
    const int hq = kvh * 4 + (w >> 1);
    const float slope = exp2f(-0.5f * (float)(hq + 1)), sink = sinks[hq];
    for (int st = 0; st < 4; ++st) {
        const int r0 = (w & 1) * 64 + st * 16, T0 = r0 >> 4;
        const bf16* qrow = Z1 + (tok0 + r0 + l15) * NZ1 + hq * 64 + g * 8;
        const bf16x8 bq0 = *(const bf16x8*)qrow, bq1 = *(const bf16x8*)(qrow + 32);
        f32x4 s[10]; float mx = -INFINITY;
#pragma unroll
        for (int kt = 0; kt < 10; ++kt) { f32x4 a = (f32x4){0.f, 0.f, 0.f, 0.f}; const LAS unsigned char* kp = Ks + ((T0 + kt) * 16 + l15) * ATT_KROW + g * 16;
            a = mfma16(*(const LAS bf16x8*)kp, bq0, a); a = mfma16(*(const LAS bf16x8*)(kp + 64), bq1, a);
#pragma unroll
            for (int j = 0; j < 4; ++j) { const int jj = (T0 + kt) * 16 + g * 4 + j, dist = r0 + l15 - jj + 128; const bool valid = (dist >= 0) && (dist < 128) && (qb > 0 || jj >= 128);
                const float sv = valid ? a[j] * 0.125f - slope * (float)dist : -INFINITY; s[kt][j] = sv; mx = fmaxf(mx, sv); } }
        mx = fmaxf(mx, __shfl_xor(mx, 16)); mx = fmaxf(mx, __shfl_xor(mx, 32)); mx = fmaxf(mx, sink);
        float ls = 0.f;
#pragma unroll
        for (int kt = 0; kt < 10; ++kt)
#pragma unroll
            for (int j = 0; j < 4; ++j) { const float p = __expf(s[kt][j] - mx); s[kt][j] = p; ls += p; }
        ls += __shfl_xor(ls, 16); ls += __shfl_xor(ls, 32);
        const float inv = 1.0f / (ls + __expf(sink - mx));
        f32x4 o[4];
#pragma unroll
        for (int dt = 0; dt < 4; ++dt) o[dt] = (f32x4){0.f, 0.f, 0.f, 0.f};
#pragma unroll
        for (int pp = 0; pp < 5; ++pp) { v4u pw; pw.x = cvtpk(s[2 * pp][0], s[2 * pp][1]); pw.y = cvtpk(s[2 * pp][2], s[2 * pp][3]); pw.z = cvtpk(s[2 * pp + 1][0], s[2 * pp + 1][1]); pw.w = cvtpk(s[2 * pp + 1][2], s[2 * pp + 1][3]);
            const bf16x8 bp = __builtin_bit_cast(bf16x8, pw);
#pragma unroll
            for (int dt = 0; dt < 4; ++dt) { const LAS unsigned char* vp = Vt + (dt * 16 + l15) * ATT_VROW + ((T0 + 2 * pp) * 16 + g * 4) * 2; const u32x2 lo = *(const LAS u32x2*)vp, hi = *(const LAS u32x2*)(vp + 32);
                const v4u av = (v4u){lo.x, lo.y, hi.x, hi.y}; o[dt] = mfma16(__builtin_bit_cast(bf16x8, av), bp, o[dt]); } }
        bf16* orow = ATT + (tok0 + r0 + l15) * 1024 + hq * 64 + g * 4;
#pragma unroll
        for (int dt = 0; dt < 4; ++dt) { u32x2 wv; wv.x = cvtpk(o[dt][0] * inv, o[dt][1] * inv); wv.y = cvtpk(o[dt][2] * inv, o[dt][3] * inv); *(u32x2*)(orow + dt * 16) = wv; }
    }
    __syncthreads();
}

constexpr int ML_QS = 0, ML_KS = 17408, ML_KWT = 34816, ML_VT = 53248, ML_PS = 60160, ML_CT = 69376, ML_A1 = 82432, ML_U = 90624, ML_IW = 98816, ML_EN = 107008, ML_WS = 115200,
              ML_BL = 123392, ML_CMX = 123520, ML_MIN = 123648, ML_MNEW = 123776, ML_DEC = 123904;
__device__ __forceinline__ void mlstm_item(LAS unsigned char* lds, const bf16* Z1, const float* G, const float* conv_w, const float* conv_b, const float* bi, const float* bfg,
                                           bf16* HT, float* SS, int item, int tid) {
    const int lane = tid & 63, w = tid >> 6, l15 = lane & 15, g = lane >> 4;
    const int bh = item >> 3, b = bh >> 2, h = bh & 3, slice = item & 7, dv0 = slice * 32;
    LAS float* A1 = (LAS float*)(lds + ML_A1); LAS float* U = (LAS float*)(lds + ML_U); LAS float* IW = (LAS float*)(lds + ML_IW); LAS float* EN = (LAS float*)(lds + ML_EN); LAS float* WS = (LAS float*)(lds + ML_WS);
    LAS float* BL = (LAS float*)(lds + ML_BL); LAS float* CMX = (LAS float*)(lds + ML_CMX); LAS float* MIN = (LAS float*)(lds + ML_MIN); LAS float* MNEW = (LAS float*)(lds + ML_MNEW); LAS float* DEC = (LAS float*)(lds + ML_DEC);
    LAS unsigned short* VT16 = (LAS unsigned short*)(lds + ML_VT); LAS unsigned short* PS16 = (LAS unsigned short*)(lds + ML_PS);
    const size_t tokb = (size_t)b * SEQ;
    { const float bih = bi[h], bfh = bfg[h];
      for (int c = w; c < 32; c += 8) { const size_t tok = tokb + c * 64 + lane;
        const float ip = G[tok * 8 + h] + bih, fp = G[tok * 8 + 4 + h] + bfh;
        const float lf = fminf(fp, 0.f) - log1pf(expf(-fabsf(fp)));
        float bt = lf;
#pragma unroll
        for (int o = 1; o < 64; o <<= 1) { const float t = __shfl_up(bt, o); if (lane >= o) bt += t; }
        const float u = ip - bt; float cm = u;
#pragma unroll
        for (int o = 1; o < 64; o <<= 1) { const float t = __shfl_up(cm, o); if (lane >= o) cm = fmaxf(cm, t); }
        A1[c * 64 + lane] = bt; U[c * 64 + lane] = u; IW[c * 64 + lane] = cm;
        if (lane == 63) { BL[c] = bt; CMX[c] = cm; } } }
    __syncthreads();
    if (tid == 0) { float m = 0.f; for (int c = 0; c < 32; ++c) { MIN[c] = m; const float bl = BL[c]; const float mn = bl + fmaxf(m, CMX[c]); MNEW[c] = mn; DEC[c] = expf(bl + m - mn); m = mn; } }
    __syncthreads();
    for (int idx = tid; idx < 2048; idx += 512) { const int c = idx >> 6; const float m_in = MIN[c], mn = MNEW[c], bt = A1[idx], u = U[idx], cm = IW[idx]; const float mt = bt + fmaxf(m_in, cm);
        A1[idx] = bt - mt; IW[idx] = expf(bt + m_in - mt); EN[idx] = expf(-mt); WS[idx] = expf(BL[c] + u - mn); }
    for (int i = tid; i < 16 * 72; i += 512) VT16[32 * 72 + i] = (i < 72) ? (unsigned short)0x3F80u : (unsigned short)0u;
    const int cg8 = tid & 31, tq = tid >> 5; const bool isk = cg8 >= 16;
    const int ccol = h * 128 + (cg8 & 15) * 8 + (isk ? 512 : 0), zcol = 1536 + ccol;
    float cw[4][8], cb[8];
#pragma unroll
    for (int j = 0; j < 4; ++j) { const f32x4 a = *(const f32x4*)(conv_w + j * 1024 + ccol), c2 = *(const f32x4*)(conv_w + j * 1024 + ccol + 4);
        cw[j][0] = a.x; cw[j][1] = a.y; cw[j][2] = a.z; cw[j][3] = a.w; cw[j][4] = c2.x; cw[j][5] = c2.y; cw[j][6] = c2.z; cw[j][7] = c2.w; }
    { const f32x4 a = *(const f32x4*)(conv_b + ccol), c2 = *(const f32x4*)(conv_b + ccol + 4); cb[0] = a.x; cb[1] = a.y; cb[2] = a.z; cb[3] = a.w; cb[4] = c2.x; cb[5] = c2.y; cb[6] = c2.z; cb[7] = c2.w; }
    v4u xr[7]; u32x2 vr;
#define ML_LOAD(cc) do { const int t0_ = (cc) * 64 + tq * 4; \
        _Pragma("unroll") for (int r_ = 0; r_ < 7; ++r_) { const int t_ = t0_ - 3 + r_; xr[r_] = (t_ >= 0) ? *(const v4u*)(Z1 + (tokb + t_) * NZ1 + zcol) : (v4u){0u, 0u, 0u, 0u}; } \
        vr = *(const u32x2*)(Z1 + (tokb + (cc) * 64 + (tid >> 3)) * NZ1 + 2560 + h * 256 + dv0 + (tid & 7) * 4); } while (0)
    ML_LOAD(0);
    f32x4 C[3];
#pragma unroll
    for (int jt = 0; jt < 3; ++jt) C[jt] = (f32x4){0.f, 0.f, 0.f, 0.f};
    __syncthreads();
    for (int c = 0; c < 32; ++c) {
        { float xf[7][8];
#pragma unroll
          for (int r = 0; r < 7; ++r) { xf[r][0] = bflo(xr[r].x); xf[r][1] = bfhi(xr[r].x); xf[r][2] = bflo(xr[r].y); xf[r][3] = bfhi(xr[r].y); xf[r][4] = bflo(xr[r].z); xf[r][5] = bfhi(xr[r].z); xf[r][6] = bflo(xr[r].w); xf[r][7] = bfhi(xr[r].w); }
          float y[4][8];
#pragma unroll
          for (int tt = 0; tt < 4; ++tt)
#pragma unroll
              for (int e = 0; e < 8; ++e) { float a = cb[e];
#pragma unroll
                  for (int j = 0; j < 4; ++j) a += cw[j][e] * xf[tt + j][e];
                  y[tt][e] = a * sigmf(a); }
          if (!isk) {
#pragma unroll
              for (int tt = 0; tt < 4; ++tt) { v4u o; o.x = cvtpk(y[tt][0], y[tt][1]); o.y = cvtpk(y[tt][2], y[tt][3]); o.z = cvtpk(y[tt][4], y[tt][5]); o.w = cvtpk(y[tt][6], y[tt][7]);
                  *(LAS v4u*)(lds + ML_QS + (tq * 4 + tt) * 272 + cg8 * 16) = o; }
          } else {
              float ws4[4];
#pragma unroll
              for (int tt = 0; tt < 4; ++tt) ws4[tt] = WS[c * 64 + tq * 4 + tt];
#pragma unroll
              for (int tt = 0; tt < 4; ++tt) {
#pragma unroll
                  for (int e = 0; e < 8; ++e) y[tt][e] *= 0.08838834764831845f;
                  v4u o; o.x = cvtpk(y[tt][0], y[tt][1]); o.y = cvtpk(y[tt][2], y[tt][3]); o.z = cvtpk(y[tt][4], y[tt][5]); o.w = cvtpk(y[tt][6], y[tt][7]);
                  *(LAS v4u*)(lds + ML_KS + (tq * 4 + tt) * 272 + (cg8 - 16) * 16) = o; }
#pragma unroll
              for (int e = 0; e < 8; ++e) { u32x2 o; o.x = cvtpk(y[0][e] * ws4[0], y[1][e] * ws4[1]); o.y = cvtpk(y[2][e] * ws4[2], y[3][e] * ws4[3]);
                  *(LAS u32x2*)(lds + ML_KWT + ((cg8 - 16) * 8 + e) * 144 + tq * 8) = o; }
          }
          { LAS unsigned short* vt = VT16 + ((tid & 7) * 4) * 72 + (tid >> 3);
            vt[0] = (unsigned short)(vr.x & 0xffffu); vt[72] = (unsigned short)(vr.x >> 16); vt[144] = (unsigned short)(vr.y & 0xffffu); vt[216] = (unsigned short)(vr.y >> 16); }
#pragma unroll
          for (int jt = 0; jt < 3; ++jt) { u32x2 o; o.x = cvtpk(C[jt][0], C[jt][1]); o.y = cvtpk(C[jt][2], C[jt][3]); *(LAS u32x2*)(lds + ML_CT + (jt * 16 + l15) * 272 + (16 * w + g * 4) * 2) = o; }
        }
        __syncthreads();
        { const int tt = w >> 1;
#pragma unroll
          for (int q2 = 0; q2 < 2; ++q2) { const int st = (w & 1) * 2 + q2; f32x4 a = (f32x4){0.f, 0.f, 0.f, 0.f};
              if (st <= tt) {
#pragma unroll
                  for (int kk = 0; kk < 4; ++kk) a = mfma16(*(const LAS bf16x8*)(lds + ML_QS + (tt * 16 + l15) * 272 + kk * 64 + g * 16), *(const LAS bf16x8*)(lds + ML_KS + (st * 16 + l15) * 272 + kk * 64 + g * 16), a); }
              const int s_ = st * 16 + l15; const float us = U[c * 64 + s_];
#pragma unroll
              for (int i = 0; i < 4; ++i) { const int t_ = tt * 16 + g * 4 + i; const float p = (s_ <= t_) ? a[i] * __expf(A1[c * 64 + t_] + us) : 0.f; PS16[t_ * 72 + s_] = (unsigned short)(cvtpk(p, 0.f) & 0xffffu); } } }
        { const float dec = DEC[c];
#pragma unroll
          for (int jt = 0; jt < 3; ++jt) C[jt] = C[jt] * dec;
#pragma unroll
          for (int ks = 0; ks < 2; ++ks) { const bf16x8 a = *(const LAS bf16x8*)(lds + ML_KWT + (16 * w + l15) * 144 + ks * 64 + g * 16);
#pragma unroll
              for (int jt = 0; jt < 3; ++jt) C[jt] = mfma16(a, *(const LAS bf16x8*)(lds + ML_VT + (jt * 16 + l15) * 144 + ks * 64 + g * 16), C[jt]); } }
        if (c + 1 < 32) ML_LOAD(c + 1);
        __syncthreads();
        if (w < 4) { f32x4 y1[3], y2[3];
#pragma unroll
          for (int jt = 0; jt < 3; ++jt) { y1[jt] = (f32x4){0.f, 0.f, 0.f, 0.f}; y2[jt] = (f32x4){0.f, 0.f, 0.f, 0.f}; }
#pragma unroll
          for (int ks = 0; ks < 2; ++ks) { const bf16x8 bp = *(const LAS bf16x8*)(lds + ML_PS + (w * 16 + l15) * 144 + ks * 64 + g * 16);
#pragma unroll
              for (int jt = 0; jt < 3; ++jt) y1[jt] = mfma16(*(const LAS bf16x8*)(lds + ML_VT + (jt * 16 + l15) * 144 + ks * 64 + g * 16), bp, y1[jt]); }
#pragma unroll
          for (int kk = 0; kk < 4; ++kk) { const bf16x8 bq = *(const LAS bf16x8*)(lds + ML_QS + (w * 16 + l15) * 272 + kk * 64 + g * 16);
#pragma unroll
              for (int jt = 0; jt < 3; ++jt) y2[jt] = mfma16(*(const LAS bf16x8*)(lds + ML_CT + (jt * 16 + l15) * 272 + kk * 64 + g * 16), bq, y2[jt]); }
          const int t_ = w * 16 + l15; const float iw = IW[c * 64 + t_], en = EN[c * 64 + t_];
          const float den = __shfl(y1[2][0] + iw * y2[2][0], l15);
          const float inv = 1.0f / fmaxf(fabsf(den), en);
          float hv[2][4]; float ss = 0.f;
#pragma unroll
          for (int jt = 0; jt < 2; ++jt)
#pragma unroll
              for (int i = 0; i < 4; ++i) { hv[jt][i] = (y1[jt][i] + iw * y2[jt][i]) * inv; ss += hv[jt][i] * hv[jt][i]; }
          ss += __shfl_xor(ss, 16); ss += __shfl_xor(ss, 32);
          const size_t tok = tokb + c * 64 + t_;
#pragma unroll
          for (int jt = 0; jt < 2; ++jt) { u32x2 o; o.x = cvtpk(hv[jt][0], hv[jt][1]); o.y = cvtpk(hv[jt][2], hv[jt][3]); *(u32x2*)(HT + tok * 1024 + h * 256 + dv0 + jt * 16 + g * 4) = o; }
          if (g == 0) SS[(tok * 4 + h) * 8 + slice] = ss; }
        __syncthreads();
    }
#undef ML_LOAD
}

__device__ __forceinline__ void headnorm_phase(bf16* HT, const float* SS, const bf16* Z1, const float* mg, int gw, int NGW, int lane) {
    for (int m = gw; m < M; m += NGW) {
#pragma unroll
        for (int jj = 0; jj < 2; ++jj) { const int ci = lane + 64 * jj, head = ci >> 5;
            const f32x4 s0 = *(const f32x4*)(SS + ((size_t)m * 4 + head) * 8), s1 = *(const f32x4*)(SS + ((size_t)m * 4 + head) * 8 + 4);
            const float r = rsqrtf(((s0.x + s0.y) + (s0.z + s0.w) + (s1.x + s1.y) + (s1.z + s1.w)) * (1.f / 256.f) + EPS);
            const v4u ht = *(const v4u*)(HT + (size_t)m * 1024 + ci * 8), mo = *(const v4u*)(Z1 + (size_t)m * NZ1 + 3584 + ci * 8);
            const f32x4 g0 = *(const f32x4*)(mg + ci * 8), g1 = *(const f32x4*)(mg + ci * 8 + 4);
            v4u o;
            o.x = cvtpk(sigmf(bflo(mo.x)) * bflo(ht.x) * r * g0.x, sigmf(bfhi(mo.x)) * bfhi(ht.x) * r * g0.y);
            o.y = cvtpk(sigmf(bflo(mo.y)) * bflo(ht.y) * r * g0.z, sigmf(bfhi(mo.y)) * bfhi(ht.y) * r * g0.w);
            o.z = cvtpk(sigmf(bflo(mo.z)) * bflo(ht.z) * r * g1.x, sigmf(bfhi(mo.z)) * bfhi(ht.z) * r * g1.y);
            o.w = cvtpk(sigmf(bflo(mo.w)) * bflo(ht.w) * r * g1.z, sigmf(bfhi(mo.w)) * bfhi(ht.w) * r * g1.w);
            *(v4u*)(HT + (size_t)m * 1024 + ci * 8) = o; }
    }
}

#ifndef USE_CG_ALL
#define USE_CG_ALL 1
#endif
struct Args { const float* in[23]; float* out; unsigned char* ws; };
enum { I_X = 0, I_F1PRE, I_F1WG, I_F1WU, I_F1WD, I_F1POST, I_MIXPRE, I_WIN, I_CONVW, I_CONVB, I_SINKS, I_BI, I_BF, I_MHG, I_WA, I_WM, I_WO, I_MIXPOST, I_F2PRE, I_F2WG, I_F2WU, I_F2WD, I_F2POST };

__global__ void __launch_bounds__(NWAVES * 64, 2) hybrid_fwd(Args args) {
    extern __shared__ __attribute__((aligned(16))) unsigned char lds_raw[];
    cg::grid_group grid = cg::this_grid();
    LAS unsigned char* lds = (LAS unsigned char*)lds_raw;
    volatile LAS unsigned* MISC = (volatile LAS unsigned*)(lds + MISC_OFF);
    const int tid = threadIdx.x, lane = tid & 63, wave = __builtin_amdgcn_readfirstlane(tid >> 6);
    const int G = gridDim.x, bx = blockIdx.x;
    const int vcu = (G % 8 == 0) ? (bx % 8) * (G / 8) + bx / 8 : bx;
    const int gw = vcu * NWAVES + wave, NGW = G * NWAVES;
    unsigned char* ws = args.ws; unsigned char* ob = (unsigned char*)args.out;
    for (int u = tid; u < (LDS_BYTES - 131072) / 4; u += NWAVES * 64) ((LAS unsigned*)(lds + 131072))[u] = 0u;
    __syncthreads();
#if !USE_CG_ALL
    XcdBarrier bar = xcd_barrier_post((unsigned*)(ws + WS_CTL), MISC + 8);
#endif

#if USE_CG_ALL
#define SEAM(first) grid.sync()
#else
#define SEAM(first) do { if (first) grid.sync(); else xcd_barrier(bar); } while (0)
#endif
#define GEMM_PHASE(MODE, PAIR, Aptr, Bptr, Kk, Nn, Optr, LDC, O2ptr, GTptr) do { \
        pg8::Gemm g_; g_.A = (const bf16*)(Aptr); g_.Bt = (const bf16*)(Bptr); g_.M = M; g_.N = (Nn); g_.K = (Kk); \
        pg8::GenSched<PAIR> S_; S_.so.init(M, (Nn), G, bx); \
        pg8::GenEpi<MODE> E_; E_.O = (bf16*)(Optr); E_.ldc = (LDC); E_.O2 = (bf16*)(O2ptr); E_.Gt = (const bf16*)(GTptr); \
        pg8::gemm_phase<pg8::GenEpi<MODE>, pg8::GenSched<PAIR>, true, true>(lds, g_, S_, E_); } while (0)

    {
        P0Ptrs P; P.f1g = args.in[I_F1WG]; P.f1u = args.in[I_F1WU]; P.f1d = args.in[I_F1WD]; P.win = args.in[I_WIN]; P.wa = args.in[I_WA]; P.wm = args.in[I_WM]; P.wo = args.in[I_WO];
        P.f2g = args.in[I_F2WG]; P.f2u = args.in[I_F2WU]; P.f2d = args.in[I_F2WD];
        P.F1GU = (bf16*)(ob + OUT_F1GU); P.F1D = (bf16*)(ob + OUT_F1D); P.WIN = (bf16*)(ws + WS_WIN); P.WUP = (bf16*)(ws + WS_WUP); P.WOUT = (bf16*)(ws + WS_WOUT); P.F2GU = (bf16*)(ws + WS_F2GU); P.F2D = (bf16*)(ws + WS_F2D);
        p0_xn(args.in[I_X], args.in[I_F1PRE], (bf16*)(ws + WS_XA), gw, NGW, lane);
        p0_weights(P, lds, gw, NGW, wave, lane);
    }
    SEAM(1);
    GEMM_PHASE(1, 0, ws + WS_XA, ob + OUT_F1GU, D, 2 * FF, ws + WS_H, FF, nullptr, nullptr);
    SEAM(0);
    GEMM_PHASE(0, 0, ws + WS_H, ob + OUT_F1D, FF, D, ws + WS_F, D, nullptr, nullptr);
    SEAM(0);
    row_phase<true, true>((const bf16*)(ws + WS_F), args.in[I_X], args.out, 0.5f, args.in[I_F1POST], args.in[I_MIXPRE], (bf16*)(ws + WS_XA), args.in[I_WIN], (float*)(ws + WS_G), lds, gw, NGW, tid, lane);
    SEAM(0);
    GEMM_PHASE(2, 0, ws + WS_XA, ws + WS_WIN, D, NZ, ws + WS_Z1, NZ1, ws + WS_Z2, nullptr);
    SEAM(0);
    for (int u = bx; u < 512; u += G) attn_unit(lds, (const bf16*)(ws + WS_Z1), (bf16*)(ws + WS_XA), args.in[I_SINKS], u, tid);
    for (int it = bx; it < 256; it += G) { mlstm_item(lds, (const bf16*)(ws + WS_Z1), (const float*)(ws + WS_G), args.in[I_CONVW], args.in[I_CONVB], args.in[I_BI], args.in[I_BF], (bf16*)(ws + WS_XA) + (size_t)M * 1024, (float*)(ws + WS_SS), it, tid); __syncthreads(); }
    SEAM(0);
    headnorm_phase((bf16*)(ws + WS_XA) + (size_t)M * 1024, (const float*)(ws + WS_SS), (const bf16*)(ws + WS_Z1), args.in[I_MHG], gw, NGW, lane);
    SEAM(0);
    GEMM_PHASE(3, 1, ws + WS_XA, ws + WS_WUP, 1024, D, ws + WS_Y, D, nullptr, ws + WS_Z2);
    SEAM(0);
    GEMM_PHASE(0, 0, ws + WS_Y, ws + WS_WOUT, D, D, ws + WS_YO, D, nullptr, nullptr);
    SEAM(0);
    row_phase<true, false>((const bf16*)(ws + WS_YO), args.out, args.out, 1.0f, args.in[I_MIXPOST], args.in[I_F2PRE], (bf16*)(ws + WS_XA), nullptr, nullptr, lds, gw, NGW, tid, lane);
    SEAM(0);
    GEMM_PHASE(1, 0, ws + WS_XA, ws + WS_F2GU, D, 2 * FF, ws + WS_H, FF, nullptr, nullptr);
    SEAM(0);
    GEMM_PHASE(0, 0, ws + WS_H, ws + WS_F2D, FF, D, ws + WS_F, D, nullptr, nullptr);
    SEAM(0);
    row_phase<false, false>((const bf16*)(ws + WS_F), args.out, args.out, 0.5f, args.in[I_F2POST], nullptr, nullptr, nullptr, nullptr, lds, gw, NGW, tid, lane);
}

extern "C" void kernel_launch(void* const* d_in, const int* in_sizes, int n_in, void* d_out, int out_size, void* d_ws, size_t ws_size, hipStream_t stream) {
    static int grid = 0;
    if (grid == 0) {
        if (n_in != 23 || in_sizes[0] != M * D || out_size != M * D || ws_size < WS_END) { fprintf(stderr, "kernel_launch: unexpected shapes (n_in %d, in0 %d, out %d, ws %zu, need %zu)\n", n_in, n_in > 0 ? in_sizes[0] : -1, out_size, ws_size, (size_t)WS_END); grid = -1; return; }
        int dev = 0, cus = 0, per_cu = 0;
        if (hipGetDevice(&dev) != hipSuccess || hipDeviceGetAttribute(&cus, hipDeviceAttributeMultiprocessorCount, dev) != hipSuccess) { grid = -1; return; }
        if (hipFuncSetAttribute((const void*)hybrid_fwd, hipFuncAttributeMaxDynamicSharedMemorySize, LDS_BYTES) != hipSuccess) { fprintf(stderr, "kernel_launch: hipFuncSetAttribute failed\n"); grid = -1; return; }
        if (hipOccupancyMaxActiveBlocksPerMultiprocessor(&per_cu, (const void*)hybrid_fwd, NWAVES * 64, LDS_BYTES) != hipSuccess || per_cu < 1) { fprintf(stderr, "kernel_launch: occupancy query says %d\n", per_cu); per_cu = 1; }
        (void)hipGetLastError();
        grid = cus * per_cu;
    }
    if (grid < 0) return;
    (void)hipMemsetAsync((char*)d_ws + WS_CTL, 0, CTL_ZERO_BYTES, stream);
    Args a{};
    for (int i = 0; i < 23; ++i) a.in[i] = (const float*)d_in[i];
    a.out = (float*)d_out; a.ws = (unsigned char*)d_ws;
    void* kargs[] = {&a};
    hipError_t e = hipLaunchCooperativeKernel((const void*)hybrid_fwd, dim3(grid), dim3(NWAVES * 64), kargs, LDS_BYTES, stream);
    if (e != hipSuccess) fprintf(stderr, "kernel_launch: cooperative launch failed: %s (grid %d)\n", hipGetErrorString(e), grid);
}
```

```cpp
#include <hip/hip_runtime.h>
#include <hip/hip_cooperative_groups.h>
#include <cstdio>
#include <cstdint>
namespace cg = cooperative_groups;
namespace pg8 {
#define PG8_LAS __attribute__((address_space(3)))
typedef unsigned short bf16_t;
typedef short bf16x8 __attribute__((ext_vector_type(8)));
typedef float f32x4 __attribute__((ext_vector_type(4)));
typedef unsigned u32x4 __attribute__((ext_vector_type(4)));
constexpr int BM = 256, BK = 64, HALF = 128, HTB = HALF * BK * 2  , STAGE_BYTES = 8 * HTB, NXCD = 8, WGM = 8;

__host__ __device__ __forceinline__ int lds_byte(int r, int c) { const int st = (r >> 4) * 2 + (c >> 5), rr = r & 15, cc = c & 31, ob = rr * 64 + cc * 2; return st * 1024 + (ob ^ (((ob >> 9) & 1) << 5)); }
__host__ __device__ __forceinline__ void stage_rc(int b, int& R, int& C) { const int st = b / 1024, sb = b % 1024, swz = sb ^ (((sb >> 9) & 1) << 5); R = (st >> 1) * 16 + swz / 64; C = (st & 1) * 32 + (swz % 64) / 2; }
__host__ __device__ __forceinline__ int perm32(int rho) { const int n = rho >> 4, i = rho & 15; return 8 * (i >> 2) + 4 * n + (i & 3); }

struct Unit { int pm, pn; };
struct Gemm { const bf16_t* A; const bf16_t* Bt; int M, N, K; };

struct StaticOrder {
    int nM, nN, nwg, G, c, wgm;
    __host__ __device__ void init(int M, int N, int G_, int c_) { nM = M / BM; nN = N / BM; nwg = nM * nN; G = G_; c = c_; wgm = WGM; }
    __host__ __device__ bool next(int i, Unit& u) const {
        const long L = (long)i * G + c; if (L >= nwg) return false;
        int wgid = (int)L; { const int q = nwg / NXCD, r = nwg % NXCD, xcd = wgid % NXCD, off = wgid / NXCD; wgid = (xcd < r ? xcd * (q + 1) : r * (q + 1) + (xcd - r) * q) + off; }
        const int nig = wgm * nN, gid = wgid / nig, fm = gid * wgm, gsz = (nM - fm) < wgm ? (nM - fm) : wgm;
        u.pm = fm + ((wgid % nig) % gsz); u.pn = (wgid % nig) / gsz; return true;
    }
    __device__ __forceinline__ void a_ready(const Unit&) const {}
    __device__ __forceinline__ void done(const Unit&) const {}
};

__device__ __forceinline__ unsigned cvt_pk_bf16(float lo, float hi) { unsigned r; asm volatile("v_cvt_pk_bf16_f32 %0, %1, %2" : "=v"(r) : "v"(lo), "v"(hi)); return r; }
template <int PAIR> struct GenSched {
    StaticOrder so; static constexpr int pair = PAIR;
    __device__ __forceinline__ bool next(int i, Unit& u) const {
        if (pair) { Unit t; if (!so.next(i >> 1, t)) return false; const int part = i & 1; u.pm = t.pm + part * 64; u.pn = t.pn + part * 8; return true; }
        return so.next(i, u);
    }
    __device__ __forceinline__ void a_ready(const Unit&) const {}
    __device__ __forceinline__ void done(const Unit&) const {}
};
__device__ __forceinline__ float bflo(unsigned w) { return __builtin_bit_cast(float, w << 16); }
__device__ __forceinline__ float bfhi(unsigned w) { return __builtin_bit_cast(float, w & 0xffff0000u); }
__device__ __forceinline__ float sigm(float x) { return __builtin_amdgcn_rcpf(1.0f + __builtin_amdgcn_exp2f(x * -1.44269504089f)); }
template <int MODE> struct GenEpi {
    static constexpr bool PERM = true, AFTER_DRAIN = false; static constexpr int mode = MODE;
    bf16_t* O; int ldc; bf16_t* O2; const bf16_t* Gt;
    __device__ __forceinline__ void operator()(const f32x4 (&acc)[2][2][4][2], const Unit& u, int wr, int wc, int fr, int fq) const {
        if constexpr (MODE == 1) {
            const int row0 = u.pm * BM + wr * 64 + fr, col0 = u.pn * 128 + wc * 32 + 8 * fq;
#pragma unroll
            for (int ai = 0; ai < 2; ++ai)
#pragma unroll
                for (int m = 0; m < 4; ++m) { bf16_t* rowp = O + (size_t)(row0 + ai * HALF + m * 16) * ldc + col0;
                    f32x4 g0 = acc[ai][0][m][0], g1 = acc[ai][0][m][1], u0 = acc[ai][1][m][0], u1 = acc[ai][1][m][1], h0, h1;
#pragma unroll
                    for (int j = 0; j < 4; ++j) { h0[j] = g0[j] * u0[j] * sigm(g0[j]); h1[j] = g1[j] * u1[j] * sigm(g1[j]); }
                    u32x4 w; w.x = cvt_pk_bf16(h0[0], h0[1]); w.y = cvt_pk_bf16(h0[2], h0[3]); w.z = cvt_pk_bf16(h1[0], h1[1]); w.w = cvt_pk_bf16(h1[2], h1[3]);
                    *(u32x4*)rowp = w; }
        } else if constexpr (MODE == 3) {
            const int part = u.pn >> 3, pn = u.pn & 7, pm = u.pm & 63;
            const int row0 = pm * BM + wr * 64 + fr, col0 = pn * BM + wc * 32 + 8 * fq;
#pragma unroll
            for (int ai = 0; ai < 2; ++ai) {
                u32x4 gt[4][2], yo[4][2];
#pragma unroll
                for (int m = 0; m < 4; ++m)
#pragma unroll
                    for (int bj = 0; bj < 2; ++bj) gt[m][bj] = *(const u32x4*)(Gt + (size_t)(row0 + ai * HALF + m * 16) * 4096 + part * 2048 + col0 + bj * HALF);
                if (part) {
#pragma unroll
                    for (int m = 0; m < 4; ++m)
#pragma unroll
                        for (int bj = 0; bj < 2; ++bj) yo[m][bj] = *(const u32x4*)(O + (size_t)(row0 + ai * HALF + m * 16) * 2048 + col0 + bj * HALF);
                } else {
#pragma unroll
                    for (int m = 0; m < 4; ++m)
#pragma unroll
                        for (int bj = 0; bj < 2; ++bj) yo[m][bj] = (u32x4){0u, 0u, 0u, 0u};
                }
#pragma unroll
                for (int m = 0; m < 4; ++m)
#pragma unroll
                    for (int bj = 0; bj < 2; ++bj) { const u32x4 g4 = gt[m][bj], y4 = yo[m][bj]; const f32x4 v0 = acc[ai][bj][m][0], v1 = acc[ai][bj][m][1];
                        float r[8];
                        r[0] = bflo(y4.x) + v0[0] * sigm(bflo(g4.x)); r[1] = bfhi(y4.x) + v0[1] * sigm(bfhi(g4.x)); r[2] = bflo(y4.y) + v0[2] * sigm(bflo(g4.y)); r[3] = bfhi(y4.y) + v0[3] * sigm(bfhi(g4.y));
                        r[4] = bflo(y4.z) + v1[0] * sigm(bflo(g4.z)); r[5] = bfhi(y4.z) + v1[1] * sigm(bfhi(g4.z)); r[6] = bflo(y4.w) + v1[2] * sigm(bflo(g4.w)); r[7] = bfhi(y4.w) + v1[3] * sigm(bfhi(g4.w));
                        u32x4 w; w.x = cvt_pk_bf16(r[0], r[1]); w.y = cvt_pk_bf16(r[2], r[3]); w.z = cvt_pk_bf16(r[4], r[5]); w.w = cvt_pk_bf16(r[6], r[7]);
                        *(u32x4*)(O + (size_t)(row0 + ai * HALF + m * 16) * 2048 + col0 + bj * HALF) = w; }
            }
        } else {
            int colt = u.pn * BM; bf16_t* base = O; int ld = ldc;
            if (mode == 2 && colt >= 4608) { base = O2; ld = 4096; colt -= 4608; }
            const int row0 = u.pm * BM + wr * 64 + fr, col0 = colt + wc * 32 + 8 * fq;
#pragma unroll
            for (int ai = 0; ai < 2; ++ai)
#pragma unroll
                for (int m = 0; m < 4; ++m) { bf16_t* rowp = base + (size_t)(row0 + ai * HALF + m * 16) * ld + col0;
#pragma unroll
                    for (int bj = 0; bj < 2; ++bj) { const f32x4 v0 = acc[ai][bj][m][0], v1 = acc[ai][bj][m][1];
                        u32x4 w; w.x = cvt_pk_bf16(v0[0], v0[1]); w.y = cvt_pk_bf16(v0[2], v0[3]); w.z = cvt_pk_bf16(v1[0], v1[1]); w.w = cvt_pk_bf16(v1[2], v1[3]);
                        *(u32x4*)(rowp + bj * HALF) = w; } }
        }
    }
};

template <class Epi, class Sched, bool ALIGN_EPI = false, bool SP2 = false>
__device__ __forceinline__ void gemm_phase(PG8_LAS unsigned char* lds, const Gemm g, const Sched& S, const Epi& E, const int wid) {
    int lane; asm volatile("v_mbcnt_lo_u32_b32 %0, -1, 0\n\tv_mbcnt_hi_u32_b32 %0, -1, %0" : "=v"(lane));
    const int tid = wid * 64 + lane, wr = wid >> 2, wc = wid & 3, fr = lane & 15, fq = lane >> 4;
    const int K = g.K, nt = K / BK;
    unsigned voffA[2], voffB[2];
#pragma unroll
    for (int i = 0; i < 2; ++i) { int R, C; stage_rc(tid * 16 + i * 8192, R, C); const int Rb = Epi::PERM ? ((R & ~31) + perm32(R & 31)) : R;
        voffA[i] = (unsigned)(R * K + C) * 2u; voffB[i] = (unsigned)(Rb * K + C) * 2u; }
    const size_t kstep = (size_t)(BK * 2);
    const size_t hstep = (size_t)HALF * K * 2;
    const size_t tstep = 2 * hstep;
    const unsigned ldsw = (unsigned)wid * 1024u;
    const int aoff = lds_byte(wr * 64 + fr, fq * 8), boff = lds_byte(wc * 32 + fr, fq * 8);
#define PG8_SA(b, h) (((b) * 2 + (h)) * HTB)
#define PG8_SB(b, h) ((4 + (b) * 2 + (h)) * HTB)
#define PG8_STAGE(bufoff, gbase, voff) do { _Pragma("unroll") for (int _i = 0; _i < 2; ++_i) \
        __builtin_amdgcn_global_load_lds((const unsigned*)((const char*)(gbase) + (voff)[_i]), (PG8_LAS unsigned*)(lds + (bufoff) + ldsw + _i * 8192), 16, 0, 0); } while (0)
#define PG8_LDA(dst, b, h) do { _Pragma("unroll") for (int m = 0; m < 4; ++m) _Pragma("unroll") for (int k = 0; k < 2; ++k) dst[m][k] = *(const PG8_LAS bf16x8*)(lds + PG8_SA(b, h) + aoff + m * 2048 + k * 1024); } while (0)
#define PG8_LDB(dst, b, h) do { _Pragma("unroll") for (int n = 0; n < 2; ++n) _Pragma("unroll") for (int k = 0; k < 2; ++k) dst[n][k] = *(const PG8_LAS bf16x8*)(lds + PG8_SB(b, h) + boff + n * 2048 + k * 1024); } while (0)
#define PG8_MMA(ai, bj, At, Bt) do { __builtin_amdgcn_s_setprio(1); _Pragma("unroll") for (int m = 0; m < 4; ++m) _Pragma("unroll") for (int n = 0; n < 2; ++n) _Pragma("unroll") for (int k = 0; k < 2; ++k) \
        acc[ai][bj][m][n] = __builtin_amdgcn_mfma_f32_16x16x32_bf16(Bt[n][k], At[m][k], acc[ai][bj][m][n], 0, 0, 0); __builtin_amdgcn_s_setprio(0); } while (0)
#define PG8_WAIT_V(n) asm volatile("s_waitcnt vmcnt(" #n ")" ::: "memory")
#define PG8_WAIT_L(n) asm volatile("s_waitcnt lgkmcnt(" #n ")" ::: "memory")
#define PG8_BAR __builtin_amdgcn_s_barrier()
#define PG8_SCHED __builtin_amdgcn_sched_barrier(0)
    Unit cur, nxt; int ui = 0;
    if (!S.next(0, cur)) return;
    f32x4 acc[2][2][4][2];
#pragma unroll
    for (int a = 0; a < 2; ++a)
#pragma unroll
        for (int b = 0; b < 2; ++b)
#pragma unroll
            for (int m = 0; m < 4; ++m)
#pragma unroll
                for (int n = 0; n < 2; ++n) acc[a][b][m][n] = (f32x4){0.f, 0.f, 0.f, 0.f};
    bf16x8 At[4][2], B0[2][2], B1[2][2];
    const char* cA = (const char*)g.A + (size_t)cur.pm * tstep; const char* cB = (const char*)g.Bt + (size_t)cur.pn * tstep;
    S.a_ready(cur);
    if constexpr (SP2) {
        PG8_STAGE(PG8_SB(0, 0), cB, voffB); PG8_STAGE(PG8_SB(0, 1), cB + hstep, voffB); PG8_STAGE(PG8_SA(0, 0), cA, voffA); PG8_STAGE(PG8_SA(0, 1), cA + hstep, voffA);
        if (wr == 1) PG8_BAR;
        PG8_WAIT_V(2); PG8_BAR;
        PG8_STAGE(PG8_SB(1, 0), cB + kstep, voffB); PG8_STAGE(PG8_SA(1, 0), cA + kstep, voffA); PG8_STAGE(PG8_SB(1, 1), cB + hstep + kstep, voffB);
        PG8_WAIT_V(6); PG8_BAR;
    } else {
        PG8_STAGE(PG8_SB(0, 0), cB, voffB); PG8_STAGE(PG8_SA(0, 0), cA, voffA); PG8_STAGE(PG8_SB(0, 1), cB + hstep, voffB); PG8_STAGE(PG8_SA(0, 1), cA + hstep, voffA);
        if (wr == 1) PG8_BAR;
        PG8_WAIT_V(4); PG8_BAR;
        PG8_STAGE(PG8_SB(1, 0), cB + kstep, voffB); PG8_STAGE(PG8_SA(1, 0), cA + kstep, voffA); PG8_STAGE(PG8_SB(1, 1), cB + hstep + kstep, voffB);
        PG8_WAIT_V(6); PG8_BAR;
    }
    for (;;) {
        const bool has_next = S.next(ui + 1, nxt);
        const char* nA = has_next ? (const char*)g.A + (size_t)nxt.pm * tstep : cA; const char* nB = has_next ? (const char*)g.Bt + (size_t)nxt.pn * tstep : cB;
        for (int t = 0; t < nt; t += 2) {
            const bool last = (t == nt - 2);
            const char* a1 = cA + (size_t)(t + 1) * kstep;
            const char* a2 = last ? nA : cA + (size_t)(t + 2) * kstep; const char* b2 = last ? nB : cB + (size_t)(t + 2) * kstep;
            const char* a3 = a2 + kstep; const char* b3 = b2 + kstep;
            if (last && has_next) S.a_ready(nxt);
            if constexpr (SP2) {
            PG8_LDB(B0, 0, 0); PG8_LDB(B1, 0, 1); PG8_SCHED; PG8_LDA(At, 0, 0); PG8_STAGE(PG8_SA(1, 1), a1 + hstep, voffA);
            PG8_WAIT_V(8); PG8_WAIT_L(0); PG8_BAR; PG8_MMA(0, 0, At, B0); PG8_MMA(0, 1, At, B1); PG8_BAR; PG8_SCHED;
            PG8_LDA(At, 0, 1); PG8_STAGE(PG8_SB(0, 0), b2, voffB); PG8_STAGE(PG8_SB(0, 1), b2 + hstep, voffB); PG8_STAGE(PG8_SA(0, 0), a2, voffA);
            PG8_WAIT_V(8); PG8_WAIT_L(0); PG8_BAR; PG8_MMA(1, 0, At, B0); PG8_MMA(1, 1, At, B1); PG8_BAR; PG8_SCHED;
            PG8_LDB(B0, 1, 0); PG8_LDB(B1, 1, 1); PG8_SCHED; PG8_LDA(At, 1, 0); PG8_STAGE(PG8_SA(0, 1), a2 + hstep, voffA);
            PG8_WAIT_V(8); PG8_WAIT_L(0); PG8_BAR; PG8_MMA(0, 0, At, B0); PG8_MMA(0, 1, At, B1); PG8_BAR; PG8_SCHED;
            PG8_LDA(At, 1, 1); PG8_STAGE(PG8_SB(1, 0), b3, voffB); PG8_STAGE(PG8_SB(1, 1), b3 + hstep, voffB); PG8_STAGE(PG8_SA(1, 0), a3, voffA);
            PG8_WAIT_V(8); PG8_WAIT_L(0); PG8_BAR; PG8_MMA(1, 0, At, B0); PG8_MMA(1, 1, At, B1); PG8_BAR; PG8_SCHED;
            } else {
            PG8_LDB(B0, 0, 0); PG8_SCHED; PG8_LDA(At, 0, 0); PG8_STAGE(PG8_SA(1, 1), a1 + hstep, voffA);
            PG8_WAIT_L(8); PG8_BAR; PG8_WAIT_L(0); PG8_MMA(0, 0, At, B0); PG8_BAR; PG8_SCHED;
            PG8_LDB(B1, 0, 1); PG8_STAGE(PG8_SB(0, 0), b2, voffB);
            PG8_BAR; PG8_WAIT_L(0); PG8_MMA(0, 1, At, B1); PG8_BAR;
            PG8_LDA(At, 0, 1); PG8_STAGE(PG8_SA(0, 0), a2, voffA);
            PG8_BAR; PG8_WAIT_L(0); PG8_MMA(1, 0, At, B0); PG8_BAR; PG8_SCHED;
            PG8_STAGE(PG8_SB(0, 1), b2 + hstep, voffB);
            PG8_WAIT_V(6); PG8_BAR; PG8_MMA(1, 1, At, B1); PG8_BAR;
            PG8_LDB(B0, 1, 0); PG8_SCHED; PG8_LDA(At, 1, 0); PG8_STAGE(PG8_SA(0, 1), a2 + hstep, voffA);
            PG8_WAIT_L(8); PG8_BAR; PG8_WAIT_L(0); PG8_MMA(0, 0, At, B0); PG8_BAR; PG8_SCHED;
            PG8_LDB(B1, 1, 1); PG8_STAGE(PG8_SB(1, 0), b3, voffB);
            PG8_BAR; PG8_WAIT_L(0); PG8_MMA(0, 1, At, B1); PG8_BAR;
            PG8_LDA(At, 1, 1); PG8_STAGE(PG8_SA(1, 0), a3, voffA);
            PG8_BAR; PG8_WAIT_L(0); PG8_MMA(1, 0, At, B0); PG8_BAR; PG8_SCHED;
            PG8_STAGE(PG8_SB(1, 1), b3 + hstep, voffB);
            PG8_WAIT_V(6); PG8_BAR; PG8_MMA(1, 1, At, B1); PG8_BAR;
            }
        }
        if constexpr (ALIGN_EPI) { if (wr == 0) PG8_BAR; }
        if constexpr (!Epi::AFTER_DRAIN) { E(acc, cur, wr, wc, fr, fq); S.done(cur); }
        if (!has_next) break;
#pragma unroll
        for (int a = 0; a < 2; ++a)
#pragma unroll
            for (int b = 0; b < 2; ++b)
#pragma unroll
                for (int m = 0; m < 4; ++m)
#pragma unroll
                    for (int n = 0; n < 2; ++n) acc[a][b][m][n] = (f32x4){0.f, 0.f, 0.f, 0.f};
        cur = nxt; cA = nA; cB = nB; ++ui;
        if constexpr (ALIGN_EPI) { if (wr == 1) PG8_BAR; }
    }
    PG8_WAIT_V(0);
    if constexpr (!ALIGN_EPI) { if (wr == 0) PG8_BAR; }
    PG8_BAR;
    if constexpr (Epi::AFTER_DRAIN) { E.fused(acc, cur, wr, wc, fr, fq, lds, wid, lane); S.done(cur); }
#undef PG8_SA
#undef PG8_SB
#undef PG8_STAGE
#undef PG8_LDA
#undef PG8_LDB
#undef PG8_MMA
#undef PG8_WAIT_V
#undef PG8_WAIT_L
#undef PG8_BAR
#undef PG8_SCHED
}
}
#define GAS __attribute__((address_space(1)))
#define LAS __attribute__((address_space(3)))
typedef unsigned short bf16;
typedef unsigned v4u __attribute__((ext_vector_type(4)));
typedef float f32x4 __attribute__((ext_vector_type(4)));
typedef short bf16x8 __attribute__((ext_vector_type(8)));
typedef GAS unsigned gu32;
typedef GAS unsigned long long gu64;
#define RLX_AGENT __ATOMIC_RELAXED, __HIP_MEMORY_SCOPE_AGENT
#define LDS_WAIT() asm volatile("s_waitcnt lgkmcnt(0)" ::: "memory")
#define VM_WAIT() asm volatile("s_waitcnt vmcnt(0)" ::: "memory")
__device__ __forceinline__ unsigned long long rt() { return __builtin_amdgcn_s_memrealtime(); }
__device__ __forceinline__ unsigned f2bf(float f) { unsigned u = __builtin_bit_cast(unsigned, f); return (u + 0x7fffu + ((u >> 16) & 1u)) >> 16; }
__device__ __forceinline__ unsigned pk2(float lo, float hi) { return f2bf(lo) | (f2bf(hi) << 16); }

#define XB_TMO      128
#define XB_XCNT(j)  (256  + 64 * (j))
#define XB_XSUB(j)  (1280 + 64 * (j))
#define XB_XGEN(j)  (2304 + 64 * (j))
#define XB_TOP      3328
#define XB_TOPGEN   3392
#define XCD_BAR_WORDS 3456
#define XB_SPIN_CAP (1u << 18)

__device__ __forceinline__ unsigned xb_ld(unsigned* p)              { return __hip_atomic_load(p, __ATOMIC_RELAXED, __HIP_MEMORY_SCOPE_AGENT); }
__device__ __forceinline__ unsigned xb_add(unsigned* p, unsigned v) { return __hip_atomic_fetch_add(p, v, __ATOMIC_RELAXED, __HIP_MEMORY_SCOPE_AGENT); }
__device__ __forceinline__ unsigned xb_xcc_id() { return (unsigned)__builtin_amdgcn_s_getreg((3 << 11) | 20) & 0xFu; }
#define XB_SPIN(cond, bar) do { unsigned _sp = 0; while (cond) { __builtin_amdgcn_s_sleep(1); \
    if ((++_sp & 255u) == 0u) { if (xb_ld(&(bar)[XB_TMO])) break; if (_sp > XB_SPIN_CAP) { atomicAdd(&(bar)[XB_TMO], 1u); break; } } } } while (0)

struct XcdBarrier {
    unsigned* bar; unsigned x;
    volatile LAS unsigned* st;
};

__device__ __forceinline__ XcdBarrier xcd_barrier_post(unsigned* bar, volatile LAS unsigned* st) {
    XcdBarrier b; b.bar = bar; b.x = xb_xcc_id(); b.st = st;
    if (threadIdx.x == 0) (void)xb_add(&bar[XB_XCNT(b.x)], 1u);
    return b;
}
__device__ __forceinline__ void xcd_barrier_complete(unsigned* bar, unsigned x, unsigned& nloc, unsigned& nx) {
    const unsigned G = gridDim.x * gridDim.y * gridDim.z;
    unsigned sum, cnt, mine, sp = 0u;
    for (;;) {
        sum = 0u; cnt = 0u; mine = 0u;
#pragma unroll
        for (unsigned j = 0; j < 16; ++j) { const unsigned c = xb_ld(&bar[XB_XCNT(j)]); sum += c; cnt += (c > 0u) ? 1u : 0u; mine = (j == x) ? c : mine; }
        if (sum == G) break;
        __builtin_amdgcn_s_sleep(1);
        if ((++sp & 255u) == 0u) { if (xb_ld(&bar[XB_TMO])) break; if (sp > XB_SPIN_CAP) { atomicAdd(&bar[XB_TMO], 1u); break; } }
    }
    nloc = mine > 0u ? mine : 1u; nx = cnt > 0u ? cnt : 1u;
}

__device__ __forceinline__ void xcd_barrier(const XcdBarrier& b) {
    asm volatile("s_waitcnt vmcnt(0)" ::: "memory");
    __syncthreads();
    if (threadIdx.x == 0) {
        unsigned* bar = b.bar;
        __builtin_amdgcn_s_waitcnt(0);
        unsigned nloc = b.st[0], nx = b.st[1];
        if (nloc == 0u) { xcd_barrier_complete(bar, b.x, nloc, nx); b.st[0] = nloc; b.st[1] = nx; }
        const unsigned old = xb_add(&bar[XB_XSUB(b.x)], 1u);
        const unsigned gen = old / nloc;
        if (old + 1u == (gen + 1u) * nloc) {
            __builtin_amdgcn_fence(__ATOMIC_RELEASE, "agent");
            asm volatile("s_waitcnt vmcnt(0)" ::: "memory");
            const unsigned og = xb_add(&bar[XB_TOP], 1u);
            const unsigned tg = og / nx;
            if (og + 1u == (tg + 1u) * nx) xb_add(&bar[XB_TOPGEN], 1u);
            else XB_SPIN(xb_ld(&bar[XB_TOPGEN]) == tg, bar);
            __builtin_amdgcn_fence(__ATOMIC_ACQUIRE, "agent");
            xb_add(&bar[XB_XGEN(b.x)], 1u);
            asm volatile("s_waitcnt vmcnt(0)" ::: "memory");
        } else {
            XB_SPIN(xb_ld(&bar[XB_XGEN(b.x)]) == gen, bar);
            __builtin_amdgcn_fence(__ATOMIC_ACQUIRE, "agent");
            asm volatile("s_waitcnt vmcnt(0)" ::: "memory");
        }
    }
    __syncthreads();
}

__device__ __forceinline__ int cur_lane() { int l; asm volatile("v_mbcnt_lo_u32_b32 %0, -1, 0\n\tv_mbcnt_hi_u32_b32 %0, -1, %0" : "=v"(l)); return l; }

constexpr int NWAVES = 8;
constexpr int M = 16384, D = 2048, FF = 5632, SEQ = 2048;
constexpr int NZ1 = 4608, NZ2 = 4096, NZ = 8704, DIN = 8712;
constexpr float EPS = 1e-6f;
constexpr size_t MiB = 1u << 20;
constexpr size_t WS_CTL = 0, CTL_ZERO_BYTES = 64 * 1024;
constexpr size_t WS_G = 1 * MiB;
constexpr size_t WS_RS = 1 * MiB + 512 * 1024;
constexpr size_t WS_SS = 2 * MiB;
constexpr size_t WS_WIN = 4 * MiB;
constexpr size_t WS_WUP = WS_WIN + (size_t)NZ * D * 2;
constexpr size_t WS_WOUT = WS_WUP + (size_t)4096 * 1024 * 2;
constexpr size_t WS_F2GU = WS_WOUT + (size_t)D * D * 2;
constexpr size_t WS_F2D = WS_F2GU + (size_t)2 * FF * D * 2;
constexpr size_t WS_WEND = WS_F2D + (size_t)D * FF * 2;
constexpr size_t WS_XA = 120 * MiB;
constexpr size_t WS_B = 184 * MiB;
constexpr size_t WS_H = WS_B, WS_F = WS_B + 176 * MiB, WS_Z1 = WS_B, WS_Z2 = WS_B + 144 * MiB, WS_Y = WS_B, WS_YO = WS_B + 144 * MiB, WS_H2 = WS_B + 176 * MiB;
constexpr size_t WS_END = WS_B + 272 * MiB;
static_assert(WS_WEND <= WS_XA, "weights fit");
static_assert(WS_END <= 512 * MiB, "workspace fits 512 MiB");
constexpr size_t OUT_F1GU = 0, OUT_F1D = (size_t)2 * FF * D * 2;
constexpr int LDS_BYTES = 157696;
constexpr int LDS_CTRL = 156672, MISC_OFF = LDS_CTRL + 320;

typedef unsigned u32x2 __attribute__((ext_vector_type(2)));
__device__ __forceinline__ float bflo(unsigned w) { return __builtin_bit_cast(float, w << 16); }
__device__ __forceinline__ float bfhi(unsigned w) { return __builtin_bit_cast(float, w & 0xffff0000u); }
__device__ __forceinline__ unsigned cvtpk(float lo, float hi) { unsigned r; asm volatile("v_cvt_pk_bf16_f32 %0, %1, %2" : "=v"(r) : "v"(lo), "v"(hi)); return r; }
__device__ __forceinline__ float sigmf(float x) { return __builtin_amdgcn_rcpf(1.0f + __builtin_amdgcn_exp2f(x * -1.44269504089f)); }
#define DPP_ADD(v, ctrl, row_mask) ((v) + __builtin_bit_cast(float, __builtin_amdgcn_update_dpp(0, __builtin_bit_cast(int, (v)), (ctrl), (row_mask), 0xf, false)))
__device__ __forceinline__ float wave_sum(float v) {
    v = DPP_ADD(v, 0x111, 0xf); v = DPP_ADD(v, 0x112, 0xf); v = DPP_ADD(v, 0x114, 0xf); v = DPP_ADD(v, 0x118, 0xf);
    v = DPP_ADD(v, 0x142, 0xa); v = DPP_ADD(v, 0x143, 0xc);
    return __builtin_bit_cast(float, __builtin_amdgcn_readlane(__builtin_bit_cast(int, v), 63));
}
__device__ __forceinline__ f32x4 mfma16(bf16x8 a, bf16x8 b, f32x4 c) { return __builtin_amdgcn_mfma_f32_16x16x32_bf16(a, b, c, 0, 0, 0); }

__device__ __forceinline__ void p0_transpose_item(const float* W, int ldw, int c0, int K, int k0, bf16* WT, int drow0, LAS float* scr, int lane, const float* gvec) {
#pragma unroll 8
    for (int i = 0; i < 32; ++i) { const int kk = 2 * i + (lane >> 5); scr[kk * 33 + (lane & 31)] = __builtin_nontemporal_load(W + (size_t)(k0 + kk) * ldw + c0 + (lane & 31)); }
    LDS_WAIT(); asm volatile("" ::: "memory");
    const int c = lane & 7;
    f32x4 ga = (f32x4){1.f, 1.f, 1.f, 1.f}, gb = ga; if (gvec) { ga = *(const f32x4*)(gvec + k0 + 8 * c); gb = *(const f32x4*)(gvec + k0 + 8 * c + 4); }
#pragma unroll
    for (int j = 0; j < 4; ++j) { const int n = (lane >> 3) + 8 * j; const LAS float* s = scr + (8 * c) * 33 + n;
        v4u o; o.x = cvtpk(s[0 * 33] * ga.x, s[1 * 33] * ga.y); o.y = cvtpk(s[2 * 33] * ga.z, s[3 * 33] * ga.w); o.z = cvtpk(s[4 * 33] * gb.x, s[5 * 33] * gb.y); o.w = cvtpk(s[6 * 33] * gb.z, s[7 * 33] * gb.w);
        *(GAS v4u*)(WT + (size_t)(drow0 + n) * K + k0 + 8 * c) = o; }
    LDS_WAIT(); asm volatile("" ::: "memory");
}
struct P0Ptrs { const float *f1g, *f1u, *f1d, *win, *wa, *wm, *wo, *f2g, *f2u, *f2d, *g1, *g2, *g3; bf16 *F1GU, *F1D, *WIN, *WUP, *WOUT, *F2GU, *F2D; };
__device__ __forceinline__ void p0_weights(const P0Ptrs& P, LAS unsigned char* lds, int gw, int NGW, int wave, int lane) {
    LAS float* scr = (LAS float*)(lds + wave * 16384);
    constexpr int I_GU = 32 * 176, I_D = 88 * 64, I_IN1 = 32 * 144, I_IN2 = 32 * 128, I_UP = 16 * 64, I_O = 32 * 64;
    constexpr int NITEMS = 2 * (2 * I_GU + I_D) + I_IN1 + I_IN2 + 2 * I_UP + I_O;
    for (int it = gw; it < NITEMS; it += NGW) {
        int r = it; const float* W; int ldw, c0, K, k0, drow0; bf16* WT; const float* gv = nullptr;
        if (r < 2 * I_GU) { const int up = r >= I_GU; if (up) r -= I_GU; const int kb = r / 176, nb = r % 176; W = up ? P.f1u : P.f1g; gv = P.g1; ldw = FF; c0 = 32 * nb; K = D; k0 = 64 * kb; WT = P.F1GU; drow0 = 256 * (nb >> 2) + 32 * (nb & 3) + (up ? 128 : 0); }
        else if ((r -= 2 * I_GU) < I_D) { const int kb = r / 64, nb = r % 64; W = P.f1d; ldw = D; c0 = 32 * nb; K = FF; k0 = 64 * kb; WT = P.F1D; drow0 = 32 * nb; }
        else if ((r -= I_D) < 2 * I_GU) { const int up = r >= I_GU; if (up) r -= I_GU; const int kb = r / 176, nb = r % 176; W = up ? P.f2u : P.f2g; gv = P.g3; ldw = FF; c0 = 32 * nb; K = D; k0 = 64 * kb; WT = P.F2GU; drow0 = 256 * (nb >> 2) + 32 * (nb & 3) + (up ? 128 : 0); }
        else if ((r -= 2 * I_GU) < I_D) { const int kb = r / 64, nb = r % 64; W = P.f2d; ldw = D; c0 = 32 * nb; K = FF; k0 = 64 * kb; WT = P.F2D; drow0 = 32 * nb; }
        else if ((r -= I_D) < I_IN1) { const int kb = r / 144, nb = r % 144; W = P.win; gv = P.g2; ldw = DIN; c0 = 32 * nb; K = D; k0 = 64 * kb; WT = P.WIN; drow0 = 32 * nb; }
        else if ((r -= I_IN1) < I_IN2) { const int kb = r / 128, nb = r % 128; W = P.win; gv = P.g2; ldw = DIN; c0 = 4616 + 32 * nb; K = D; k0 = 64 * kb; WT = P.WIN; drow0 = 4608 + 32 * nb; }
        else if ((r -= I_IN2) < 2 * I_UP) { const int m2 = r >= I_UP; if (m2) r -= I_UP; const int kb = r / 64, nb = r % 64; W = m2 ? P.wm : P.wa; ldw = D; c0 = 32 * nb; K = 1024; k0 = 64 * kb; WT = P.WUP; drow0 = (m2 ? 2048 : 0) + 32 * nb; }
        else { r -= 2 * I_UP; const int kb = r / 64, nb = r % 64; W = P.wo; ldw = D; c0 = 32 * nb; K = D; k0 = 64 * kb; WT = P.WOUT; drow0 = 32 * nb; }
        p0_transpose_item(W, ldw, c0, K, k0, WT, drow0, scr, lane, gv);
    }
}
__device__ __forceinline__ void p0_xn(const float* x, bf16* XB, float* RS, int gw, int NGW, int lane) {
    for (int m = gw; m < M; m += NGW) {
        const f32x4* xr = (const f32x4*)(x + (size_t)m * D) + lane; f32x4 v[8]; float s = 0.f;
#pragma unroll
        for (int j = 0; j < 8; ++j) { v[j] = __builtin_nontemporal_load(xr + 64 * j); s += (v[j].x * v[j].x + v[j].y * v[j].y) + (v[j].z * v[j].z + v[j].w * v[j].w); }
        const float ms = wave_sum(s) * (1.f / D) + EPS, rstd = rsqrtf(ms);
        u32x2* o = (u32x2*)(XB + (size_t)m * D) + lane;
#pragma unroll
        for (int j = 0; j < 8; ++j) { u32x2 w; w.x = cvtpk(v[j].x * rstd, v[j].y * rstd); w.y = cvtpk(v[j].z * rstd, v[j].w * rstd); o[64 * j] = w; }
        if (lane == 0) RS[m] = sqrtf(ms);
    }
}

constexpr int HP = 2048;
template <bool OUT_F32, bool GATES>
__device__ __forceinline__ void row_phase(const bf16* src, const bf16* resid, const float* rms_in, void* outp, float* rms_out, float scale, const float* g_post, const float* g_next,
                                          const float* win, float* G, LAS unsigned char* lds, int gw, int NGW, int tid, int lane) {
    if (GATES) {
        for (int idx = tid; idx < 4096; idx += NWAVES * 64) { const int k = idx >> 1, hf = idx & 1; const f32x4 v = *(const f32x4*)(win + (size_t)k * DIN + 4608 + hf * 4);
            *(LAS f32x4*)(lds + k * 32 + (k >> 3) * 16 + hf * 16) = v; }
        __syncthreads();
    }
    for (int m = gw; m < M; m += NGW) {
        int ln = lane; asm volatile("" : "+v"(ln));
        const v4u* sr = (const v4u*)(src + (size_t)m * D) + ln; const v4u* rr = (const v4u*)(resid + (size_t)m * D) + ln; v4u sw[4], rw[4];
#pragma unroll
        for (int j = 0; j < 4; ++j) sw[j] = __builtin_nontemporal_load(sr + 64 * j);
#pragma unroll
        for (int j = 0; j < 4; ++j) rw[j] = __builtin_nontemporal_load(rr + 64 * j);
        const float rin = rms_in[m];
        float f[4][8]; float s = 0.f;
#pragma unroll
        for (int j = 0; j < 4; ++j) { f[j][0] = bflo(sw[j].x); f[j][1] = bfhi(sw[j].x); f[j][2] = bflo(sw[j].y); f[j][3] = bfhi(sw[j].y); f[j][4] = bflo(sw[j].z); f[j][5] = bfhi(sw[j].z); f[j][6] = bflo(sw[j].w); f[j][7] = bfhi(sw[j].w);
#pragma unroll
            for (int e = 0; e < 8; ++e) s += f[j][e] * f[j][e]; }
        const float rstd = rsqrtf(wave_sum(s) * (1.f / D) + EPS) * scale;
        float s2 = 0.f;
#pragma unroll
        for (int j = 0; j < 4; ++j) { const f32x4 ga_ = ((const f32x4*)g_post)[128 * j + 2 * ln], gb_ = ((const f32x4*)g_post)[128 * j + 2 * ln + 1];
            f[j][0] = bflo(rw[j].x) * rin + f[j][0] * rstd * ga_.x; f[j][1] = bfhi(rw[j].x) * rin + f[j][1] * rstd * ga_.y; f[j][2] = bflo(rw[j].y) * rin + f[j][2] * rstd * ga_.z; f[j][3] = bfhi(rw[j].y) * rin + f[j][3] * rstd * ga_.w;
            f[j][4] = bflo(rw[j].z) * rin + f[j][4] * rstd * gb_.x; f[j][5] = bfhi(rw[j].z) * rin + f[j][5] * rstd * gb_.y; f[j][6] = bflo(rw[j].w) * rin + f[j][6] * rstd * gb_.z; f[j][7] = bfhi(rw[j].w) * rin + f[j][7] * rstd * gb_.w;
            if (OUT_F32) { f32x4* oo = (f32x4*)((float*)outp + (size_t)m * D) + 2 * ln; __builtin_nontemporal_store((f32x4){f[j][0], f[j][1], f[j][2], f[j][3]}, oo + 128 * j); __builtin_nontemporal_store((f32x4){f[j][4], f[j][5], f[j][6], f[j][7]}, oo + 128 * j + 1); }
#pragma unroll
            for (int e = 0; e < 8; ++e) s2 += f[j][e] * f[j][e]; }
        if (!OUT_F32) {
            const float ms2 = wave_sum(s2) * (1.f / D) + EPS, rstd2 = rsqrtf(ms2);
            if (ln == 0) rms_out[m] = sqrtf(ms2);
            v4u* o = (v4u*)((bf16*)outp + (size_t)m * D) + ln;
#pragma unroll
            for (int j = 0; j < 4; ++j) {
#pragma unroll
                for (int e = 0; e < 8; ++e) f[j][e] *= rstd2;
                v4u w; w.x = cvtpk(f[j][0], f[j][1]); w.y = cvtpk(f[j][2], f[j][3]); w.z = cvtpk(f[j][4], f[j][5]); w.w = cvtpk(f[j][6], f[j][7]); o[64 * j] = w; }
            if (GATES) {
                float ga[8];
#pragma unroll
                for (int c = 0; c < 8; ++c) ga[c] = 0.f;
#pragma unroll
                for (int j = 0; j < 4; ++j) { const f32x4 ga_ = ((const f32x4*)g_next)[128 * j + 2 * ln], gb_ = ((const f32x4*)g_next)[128 * j + 2 * ln + 1];
                    f[j][0] *= ga_.x; f[j][1] *= ga_.y; f[j][2] *= ga_.z; f[j][3] *= ga_.w; f[j][4] *= gb_.x; f[j][5] *= gb_.y; f[j][6] *= gb_.z; f[j][7] *= gb_.w;
#pragma unroll
                    for (int e = 0; e < 8; ++e) { const LAS unsigned char* p = lds + 17408 * j + 272 * ln + 32 * e; const f32x4 w0 = *(const LAS f32x4*)p, w1 = *(const LAS f32x4*)(p + 16); const float uu = f[j][e];
                        ga[0] += uu * w0.x; ga[1] += uu * w0.y; ga[2] += uu * w0.z; ga[3] += uu * w0.w; ga[4] += uu * w1.x; ga[5] += uu * w1.y; ga[6] += uu * w1.z; ga[7] += uu * w1.w; } }
#pragma unroll
                for (int c = 0; c < 8; ++c) ga[c] = wave_sum(ga[c]);
                if (ln == 0) { *(f32x4*)(G + (size_t)m * 8) = (f32x4){ga[0], ga[1], ga[2], ga[3]}; *(f32x4*)(G + (size_t)m * 8 + 4) = (f32x4){ga[4], ga[5], ga[6], ga[7]}; }
            }
        }
    }
}

constexpr int ATT_KS = 0, ATT_KROW = 144, ATT_VT = 39168, ATT_VROW = 560;
__device__ __forceinline__ void attn_unit(LAS unsigned char* lds, const bf16* Z1, bf16* ATT, const float* sinks, int unit, int tid) {
    const int lane = tid & 63, w = tid >> 6, l15 = lane & 15, g = lane >> 4;
    const int b = unit >> 6, qb = (unit >> 2) & 15, kvh = unit & 3;
    LAS unsigned char* Ks = lds + ATT_KS; LAS unsigned char* Vt = lds + ATT_VT;
    const size_t tok0 = (size_t)b * SEQ + qb * 128;
#pragma unroll
    for (int i = 0; i < 4; ++i) { const int id = tid + 512 * i, key = id >> 3, part = id & 7;
        v4u kv = (v4u){0u, 0u, 0u, 0u}, vv = (v4u){0u, 0u, 0u, 0u};
        if (qb > 0 || key >= 128) { const bf16* rowp = Z1 + (tok0 + key - 128) * NZ1; kv = *(const v4u*)(rowp + 1024 + kvh * 64 + part * 8); vv = *(const v4u*)(rowp + 1280 + kvh * 64 + part * 8); }
        *(LAS v4u*)(Ks + key * ATT_KROW + part * 16) = kv;
        LAS unsigned short* vt = (LAS unsigned short*)(Vt + (part * 8) * ATT_VROW + key * 2);
        vt[0 * 280] = (unsigned short)(vv.x & 0xffffu); vt[1 * 280] = (unsigned short)(vv.x >> 16); vt[2 * 280] = (unsigned short)(vv.y & 0xffffu); vt[3 * 280] = (unsigned short)(vv.y >> 16);
        vt[4 * 280] = (unsigned short)(vv.z & 0xffffu); vt[5 * 280] = (unsigned short)(vv.z >> 16); vt[6 * 280] = (unsigned short)(vv.w & 0xffffu); vt[7 * 280] = (unsigned short)(vv.w >> 16); }
    if (tid < 128) { const int key = 256 + (tid >> 3), part = tid & 7; *(LAS v4u*)(Ks + key * ATT_KROW + part * 16) = (v4u){0u, 0u, 0u, 0u}; }
    else if (tid < 256) { const int t2 = tid - 128, d = t2 >> 1, hf = t2 & 1; *(LAS v4u*)(Vt + d * ATT_VROW + 512 + hf * 16) = (v4u){0u, 0u, 0u, 0u}; }
    __syncthreads();
    const int hq = kvh * 4 + (w >> 1);
    const float slope = exp2f(-0.5f * (float)(hq + 1)), sink = sinks[hq];
    const int d0 = l15 - 4 * g; const float sb = slope * (float)(d0 + 128);
    for (int st = 0; st < 4; ++st) {
        const int r0 = (w & 1) * 64 + st * 16, T0 = r0 >> 4;
        const bf16* qrow = Z1 + (tok0 + r0 + l15) * NZ1 + hq * 64 + g * 8;
        const bf16x8 bq0 = *(const bf16x8*)qrow, bq1 = *(const bf16x8*)(qrow + 32);
        f32x4 s[9]; float mx = -INFINITY;
#pragma unroll
        for (int kt = 0; kt < 9; ++kt) { f32x4 a = (f32x4){0.f, 0.f, 0.f, 0.f}; const LAS unsigned char* kp = Ks + ((T0 + kt) * 16 + l15) * ATT_KROW + g * 16;
            a = mfma16(*(const LAS bf16x8*)kp, bq0, a); a = mfma16(*(const LAS bf16x8*)(kp + 64), bq1, a);
            const bool tile_ok = (qb > 0) || (T0 + kt >= 8);
#pragma unroll
            for (int j = 0; j < 4; ++j) { float sv = a[j] * 0.125f + (slope * (float)(16 * kt + j) - sb);
                bool valid = tile_ok; if (kt == 0) valid = valid && (d0 < j); if (kt == 8) valid = valid && (d0 >= j);
                sv = valid ? sv : -INFINITY; s[kt][j] = sv; mx = fmaxf(mx, sv); } }
        mx = fmaxf(mx, __shfl_xor(mx, 16)); mx = fmaxf(mx, __shfl_xor(mx, 32)); mx = fmaxf(mx, sink);
        float ls = 0.f;
#pragma unroll
        for (int kt = 0; kt < 9; ++kt)
#pragma unroll
            for (int j = 0; j < 4; ++j) { const float p = __expf(s[kt][j] - mx); s[kt][j] = p; ls += p; }
        ls += __shfl_xor(ls, 16); ls += __shfl_xor(ls, 32);
        const float inv = 1.0f / (ls + __expf(sink - mx));
        f32x4 o[4];
#pragma unroll
        for (int dt = 0; dt < 4; ++dt) o[dt] = (f32x4){0.f, 0.f, 0.f, 0.f};
#pragma unroll
        for (int pp = 0; pp < 5; ++pp) { v4u pw; pw.x = cvtpk(s[2 * pp][0], s[2 * pp][1]); pw.y = cvtpk(s[2 * pp][2], s[2 * pp][3]);
            if (pp < 4) { pw.z = cvtpk(s[(pp < 4) ? 2 * pp + 1 : 0][0], s[(pp < 4) ? 2 * pp + 1 : 0][1]); pw.w = cvtpk(s[(pp < 4) ? 2 * pp + 1 : 0][2], s[(pp < 4) ? 2 * pp + 1 : 0][3]); } else { pw.z = 0u; pw.w = 0u; }
            const bf16x8 bp = __builtin_bit_cast(bf16x8, pw);
#pragma unroll
            for (int dt = 0; dt < 4; ++dt) { const LAS unsigned char* vp = Vt + (dt * 16 + l15) * ATT_VROW + ((T0 + 2 * pp) * 16 + g * 4) * 2; const u32x2 lo = *(const LAS u32x2*)vp, hi = *(const LAS u32x2*)(vp + 32);
                const v4u av = (v4u){lo.x, lo.y, hi.x, hi.y}; o[dt] = mfma16(__builtin_bit_cast(bf16x8, av), bp, o[dt]); } }
        bf16* orow = ATT + (tok0 + r0 + l15) * 1024 + hq * 64 + g * 4;
#pragma unroll
        for (int dt = 0; dt < 4; ++dt) { u32x2 wv; wv.x = cvtpk(o[dt][0] * inv, o[dt][1] * inv); wv.y = cvtpk(o[dt][2] * inv, o[dt][3] * inv); *(u32x2*)(orow + dt * 16) = wv; }
    }
    __syncthreads();
}

__device__ __forceinline__ void conv_prepass(const bf16* Z1, const float* conv_w, const float* conv_b, bf16* QKc, int gtid, int nthreads) {
    for (int it = gtid; it < (M / 4) * 128; it += nthreads) {
        const int cgp = it & 127, tquad = it >> 7, ccol = cgp * 8, tok0 = tquad * 4, ts = tok0 & (SEQ - 1);
        v4u xr[7];
#pragma unroll
        for (int r = 0; r < 7; ++r) xr[r] = (ts - 3 + r >= 0) ? *(const v4u*)(Z1 + (size_t)(tok0 - 3 + r) * NZ1 + 1536 + ccol) : (v4u){0u, 0u, 0u, 0u};
        float cw[4][8], cb[8];
#pragma unroll
        for (int j = 0; j < 4; ++j) { const f32x4 a = *(const f32x4*)(conv_w + j * 1024 + ccol), c2 = *(const f32x4*)(conv_w + j * 1024 + ccol + 4);
            cw[j][0] = a.x; cw[j][1] = a.y; cw[j][2] = a.z; cw[j][3] = a.w; cw[j][4] = c2.x; cw[j][5] = c2.y; cw[j][6] = c2.z; cw[j][7] = c2.w; }
        { const f32x4 a = *(const f32x4*)(conv_b + ccol), c2 = *(const f32x4*)(conv_b + ccol + 4); cb[0] = a.x; cb[1] = a.y; cb[2] = a.z; cb[3] = a.w; cb[4] = c2.x; cb[5] = c2.y; cb[6] = c2.z; cb[7] = c2.w; }
        const float osc = (ccol >= 512) ? 0.08838834764831845f : 1.0f;
#pragma unroll
        for (int tt = 0; tt < 4; ++tt) { float y[8];
#pragma unroll
            for (int e = 0; e < 8; ++e) y[e] = cb[e];
#pragma unroll
            for (int j = 0; j < 4; ++j) { const v4u xx = xr[tt + j];
                y[0] += cw[j][0] * bflo(xx.x); y[1] += cw[j][1] * bfhi(xx.x); y[2] += cw[j][2] * bflo(xx.y); y[3] += cw[j][3] * bfhi(xx.y);
                y[4] += cw[j][4] * bflo(xx.z); y[5] += cw[j][5] * bfhi(xx.z); y[6] += cw[j][6] * bflo(xx.w); y[7] += cw[j][7] * bfhi(xx.w); }
#pragma unroll
            for (int e = 0; e < 8; ++e) y[e] = y[e] * sigmf(y[e]) * osc;
            v4u o; o.x = cvtpk(y[0], y[1]); o.y = cvtpk(y[2], y[3]); o.z = cvtpk(y[4], y[5]); o.w = cvtpk(y[6], y[7]);
            *(v4u*)(QKc + (size_t)(tok0 + tt) * 1024 + ccol) = o; }
    }
}

constexpr int ML_QS = 0, ML_KS = 34816, ML_KWT = 52224, ML_VT = 70656, ML_PS = 84480, ML_CT = 102912, ML_U = 129024, ML_A1 = 137216, ML_MT = 145408,
              ML_BL = 153600, ML_CMX = 153728, ML_MIN = 153856, ML_MNEW = 153984, ML_DEC = 154112;
constexpr int ML_QS_SZ = 17408, ML_VT_SZ = 6912, ML_PS_SZ = 9216, ML_CT_SZ = 13056;
__device__ __forceinline__ void mlstm_item(LAS unsigned char* lds, const bf16* Z1, const bf16* QKc, const float* G, const float* bi, const float* bfg,
                                           bf16* HT, float* SS, int item, int tid) {
    const int lane = tid & 63, w = __builtin_amdgcn_readfirstlane(tid >> 6), l15 = lane & 15, g = lane >> 4;
    const int bh = item >> 3, b = bh >> 2, h = bh & 3, slice = item & 7, dv0 = slice * 32;
    LAS float* U = (LAS float*)(lds + ML_U); LAS float* A1 = (LAS float*)(lds + ML_A1); LAS float* MT = (LAS float*)(lds + ML_MT);
    LAS float* BL = (LAS float*)(lds + ML_BL); LAS float* CMX = (LAS float*)(lds + ML_CMX); LAS float* MIN = (LAS float*)(lds + ML_MIN); LAS float* MNEW = (LAS float*)(lds + ML_MNEW); LAS float* DEC = (LAS float*)(lds + ML_DEC);
    const size_t tokb = (size_t)b * SEQ;
    { const float bih = bi[h], bfh = bfg[h];
      for (int c = w; c < 32; c += 8) { const size_t tok = tokb + c * 64 + lane;
        const float ip = G[tok * 8 + h] + bih, fp = G[tok * 8 + 4 + h] + bfh;
        const float lf = fminf(fp, 0.f) - log1pf(expf(-fabsf(fp)));
        float bt = lf;
#pragma unroll
        for (int o = 1; o < 64; o <<= 1) { const float t = __shfl_up(bt, o); if (lane >= o) bt += t; }
        const float u = ip - bt; float cm = u;
#pragma unroll
        for (int o = 1; o < 64; o <<= 1) { const float t = __shfl_up(cm, o); if (lane >= o) cm = fmaxf(cm, t); }
        A1[c * 64 + lane] = bt; U[c * 64 + lane] = u; MT[c * 64 + lane] = cm;
        if (lane == 63) { BL[c] = bt; CMX[c] = cm; } } }
    for (int i = tid; i < 2 * ML_PS_SZ / 16; i += 512) *(LAS v4u*)(lds + ML_PS + i * 16) = (v4u){0u, 0u, 0u, 0u};
    for (int i = tid; i < 2 * 16 * 72; i += 512) { const int bsel = i / (16 * 72), r = i % (16 * 72); ((LAS unsigned short*)(lds + ML_VT + bsel * ML_VT_SZ))[32 * 72 + r] = (r < 72) ? (unsigned short)0x3F80u : (unsigned short)0u; }
    __syncthreads();
    if (tid == 0) { float m = 0.f; for (int c = 0; c < 32; ++c) { MIN[c] = m; const float bl = BL[c]; const float mn = bl + fmaxf(m, CMX[c]); MNEW[c] = mn; DEC[c] = expf(bl + m - mn); m = mn; } }
    __syncthreads();
    for (int idx = tid; idx < 2048; idx += 512) { const int c = idx >> 6; const float bt = A1[idx], cm = MT[idx]; const float mt = bt + fmaxf(MIN[c], cm); A1[idx] = bt - mt; MT[idx] = mt; }
    const int tb = tid & 255, cg8 = tb & 31, tq = tb >> 5; const bool isk = cg8 >= 16;
    const int ccol = h * 128 + (cg8 & 15) * 8 + (isk ? 512 : 0);
    v4u xr[3][8], vr[3]; f32x4 C[2][3];
#pragma unroll
    for (int s3 = 0; s3 < 3; ++s3) {
#pragma unroll
        for (int r = 0; r < 8; ++r) xr[s3][r] = (v4u){0u, 0u, 0u, 0u};
        vr[s3] = (v4u){0u, 0u, 0u, 0u}; }
#pragma unroll
    for (int d2 = 0; d2 < 2; ++d2)
#pragma unroll
        for (int jt = 0; jt < 3; ++jt) C[d2][jt] = (f32x4){0.f, 0.f, 0.f, 0.f};
#define ML_LOAD(cc, SET) do { const int t0_ = (cc) * 64 + tq * 8; \
        _Pragma("unroll") for (int r_ = 0; r_ < 8; ++r_) xr[SET][r_] = *(const v4u*)(QKc + (tokb + t0_ + r_) * 1024 + ccol); \
        vr[SET] = *(const v4u*)(Z1 + (tokb + (cc) * 64 + (tb >> 2)) * NZ1 + 2560 + h * 256 + dv0 + (tb & 3) * 8); } while (0)
    if (w >= 4) { ML_LOAD(0, 0); ML_LOAD(1, 1); ML_LOAD(2, 2); }
    __syncthreads();
#define ML_BAR() do { asm volatile("s_waitcnt lgkmcnt(0)" ::: "memory"); __builtin_amdgcn_s_barrier(); asm volatile("" ::: "memory"); } while (0)
    if (w >= 4) {
    for (int i3 = 0; i3 < 33; i3 += 3) {
#pragma unroll
    for (int u3 = 0; u3 < 3; ++u3) {
        const int i = i3 + u3, bo = i & 1, ic = (i < 32) ? i : 31;
            {
                LAS unsigned char* QSb = lds + ML_QS + bo * ML_QS_SZ; LAS unsigned short* VT16 = (LAS unsigned short*)(lds + ML_VT + bo * ML_VT_SZ);
                const float blc = BL[ic], mnc = MNEW[ic];
#pragma unroll
                for (int hh = 0; hh < 2; ++hh) { float y[4][8];
#pragma unroll
                    for (int tt = 0; tt < 4; ++tt) { const v4u xx = xr[u3][hh * 4 + tt];
                        y[tt][0] = bflo(xx.x); y[tt][1] = bfhi(xx.x); y[tt][2] = bflo(xx.y); y[tt][3] = bfhi(xx.y); y[tt][4] = bflo(xx.z); y[tt][5] = bfhi(xx.z); y[tt][6] = bflo(xx.w); y[tt][7] = bfhi(xx.w); }
                    const int tl = tq * 8 + hh * 4;
                    if (!isk) {
#pragma unroll
                        for (int tt = 0; tt < 4; ++tt) *(LAS v4u*)(QSb + (tl + tt) * 272 + cg8 * 16) = xr[u3][hh * 4 + tt];
                    } else {
                        float ws4[4];
#pragma unroll
                        for (int tt = 0; tt < 4; ++tt) ws4[tt] = __expf(blc + U[ic * 64 + tl + tt] - mnc);
#pragma unroll
                        for (int tt = 0; tt < 4; ++tt) *(LAS v4u*)(lds + ML_KS + (tl + tt) * 272 + (cg8 - 16) * 16) = xr[u3][hh * 4 + tt];
#pragma unroll
                        for (int e = 0; e < 8; ++e) { u32x2 o; o.x = cvtpk(y[0][e] * ws4[0], y[1][e] * ws4[1]); o.y = cvtpk(y[2][e] * ws4[2], y[3][e] * ws4[3]);
                            *(LAS u32x2*)(lds + ML_KWT + ((cg8 - 16) * 8 + e) * 144 + tl * 2) = o; }
                    } }
                { LAS unsigned short* vt = VT16 + ((tb & 3) * 8) * 72 + (tb >> 2);
                  vt[0 * 72] = (unsigned short)(vr[u3].x & 0xffffu); vt[1 * 72] = (unsigned short)(vr[u3].x >> 16); vt[2 * 72] = (unsigned short)(vr[u3].y & 0xffffu); vt[3 * 72] = (unsigned short)(vr[u3].y >> 16);
                  vt[4 * 72] = (unsigned short)(vr[u3].z & 0xffffu); vt[5 * 72] = (unsigned short)(vr[u3].z >> 16); vt[6 * 72] = (unsigned short)(vr[u3].w & 0xffffu); vt[7 * 72] = (unsigned short)(vr[u3].w >> 16); }
                ML_LOAD((i + 3 < 32) ? i + 3 : 31, u3);
            }
        ML_BAR();
        if (i < 32) {
            {
                LAS unsigned char* CTb = lds + ML_CT + bo * ML_CT_SZ; const LAS unsigned char* VTb = lds + ML_VT + bo * ML_VT_SZ; const int dk0 = 32 * (w - 4);
#pragma unroll
                for (int d2 = 0; d2 < 2; ++d2)
#pragma unroll
                    for (int jt = 0; jt < 3; ++jt) { u32x2 o; o.x = cvtpk(C[d2][jt][0], C[d2][jt][1]); o.y = cvtpk(C[d2][jt][2], C[d2][jt][3]); *(LAS u32x2*)(CTb + (jt * 16 + l15) * 272 + (dk0 + 16 * d2 + g * 4) * 2) = o; }
                const float dec = DEC[i];
#pragma unroll
                for (int d2 = 0; d2 < 2; ++d2)
#pragma unroll
                    for (int jt = 0; jt < 3; ++jt) C[d2][jt] = C[d2][jt] * dec;
#pragma unroll
                for (int ks = 0; ks < 2; ++ks) { bf16x8 bv[3];
#pragma unroll
                    for (int jt = 0; jt < 3; ++jt) bv[jt] = *(const LAS bf16x8*)(VTb + (jt * 16 + l15) * 144 + ks * 64 + g * 16);
#pragma unroll
                    for (int d2 = 0; d2 < 2; ++d2) { const bf16x8 a = *(const LAS bf16x8*)(lds + ML_KWT + (dk0 + 16 * d2 + l15) * 144 + ks * 64 + g * 16);
#pragma unroll
                        for (int jt = 0; jt < 3; ++jt) C[d2][jt] = mfma16(a, bv[jt], C[d2][jt]); } }
            }
        }
        ML_BAR();
    } }
    } else {
    for (int i = 0; i <= 32; ++i) {
        const int bo = i & 1;
        if (i >= 1) {
            const int c = i - 1, co = c & 1;
            const LAS unsigned char* QSb = lds + ML_QS + co * ML_QS_SZ; const LAS unsigned char* VTb = lds + ML_VT + co * ML_VT_SZ; const LAS unsigned char* PSb = lds + ML_PS + co * ML_PS_SZ; const LAS unsigned char* CTb = lds + ML_CT + co * ML_CT_SZ;
            f32x4 y1[3], y2[3];
#pragma unroll
            for (int jt = 0; jt < 3; ++jt) { y1[jt] = (f32x4){0.f, 0.f, 0.f, 0.f}; y2[jt] = (f32x4){0.f, 0.f, 0.f, 0.f}; }
#pragma unroll
            for (int ks = 0; ks < 2; ++ks) { const bf16x8 bp = *(const LAS bf16x8*)(PSb + (w * 16 + l15) * 144 + ks * 64 + g * 16);
#pragma unroll
                for (int jt = 0; jt < 3; ++jt) y1[jt] = mfma16(*(const LAS bf16x8*)(VTb + (jt * 16 + l15) * 144 + ks * 64 + g * 16), bp, y1[jt]); }
#pragma unroll
            for (int kk = 0; kk < 4; ++kk) { const bf16x8 bq = *(const LAS bf16x8*)(QSb + (w * 16 + l15) * 272 + kk * 64 + g * 16);
#pragma unroll
                for (int jt = 0; jt < 3; ++jt) y2[jt] = mfma16(*(const LAS bf16x8*)(CTb + (jt * 16 + l15) * 272 + kk * 64 + g * 16), bq, y2[jt]); }
            const int t_ = w * 16 + l15; const float iw = __expf(A1[c * 64 + t_] + MIN[c]), en = __expf(-MT[c * 64 + t_]);
            const float den = __shfl(y1[2][0] + iw * y2[2][0], l15);
            const float inv = 1.0f / fmaxf(fabsf(den), en);
            float hv[2][4]; float ss = 0.f;
#pragma unroll
            for (int jt = 0; jt < 2; ++jt)
#pragma unroll
                for (int q = 0; q < 4; ++q) { hv[jt][q] = (y1[jt][q] + iw * y2[jt][q]) * inv; ss += hv[jt][q] * hv[jt][q]; }
            ss += __shfl_xor(ss, 16); ss += __shfl_xor(ss, 32);
            const size_t tok = tokb + c * 64 + t_;
#pragma unroll
            for (int jt = 0; jt < 2; ++jt) { u32x2 o; o.x = cvtpk(hv[jt][0], hv[jt][1]); o.y = cvtpk(hv[jt][2], hv[jt][3]); *(u32x2*)(HT + tok * 1024 + h * 256 + dv0 + jt * 16 + g * 4) = o; }
            if (g == 0) SS[(tok * 4 + h) * 8 + slice] = ss;
        }
        ML_BAR();
        if (i < 32) {
            {
                const LAS unsigned char* QSb = lds + ML_QS + bo * ML_QS_SZ; LAS unsigned short* PS16 = (LAS unsigned short*)(lds + ML_PS + bo * ML_PS_SZ);
                const int ntile = (w < 2) ? 2 : 3;
                for (int q2 = 0; q2 < ntile; ++q2) {
                    int tt, st;
                    if (w == 0) { tt = 3; st = q2; } else if (w == 1) { tt = 3; st = 2 + q2; } else if (w == 2) { tt = 2; st = q2; } else { tt = (q2 < 2) ? 1 : 0; st = (q2 < 2) ? q2 : 0; }
                    f32x4 a = (f32x4){0.f, 0.f, 0.f, 0.f};
#pragma unroll
                    for (int kk = 0; kk < 4; ++kk) a = mfma16(*(const LAS bf16x8*)(QSb + (tt * 16 + l15) * 272 + kk * 64 + g * 16), *(const LAS bf16x8*)(lds + ML_KS + (st * 16 + l15) * 272 + kk * 64 + g * 16), a);
                    const int s_ = st * 16 + l15; const float us = U[i * 64 + s_];
#pragma unroll
                    for (int q = 0; q < 4; ++q) { const int t_ = tt * 16 + g * 4 + q; const float p = (s_ <= t_) ? a[q] * __expf(A1[i * 64 + t_] + us) : 0.f; PS16[t_ * 72 + s_] = (unsigned short)(cvtpk(p, 0.f) & 0xffffu); } }
            }
        }
        ML_BAR();
    }
    }
#undef ML_BAR
#undef ML_LOAD
}

__device__ __forceinline__ void headnorm_phase(bf16* HT, const float* SS, const bf16* Z1, const float* mg, int gw, int NGW, int lane) {
    for (int m = gw; m < M; m += NGW) {
#pragma unroll
        for (int jj = 0; jj < 2; ++jj) { const int ci = lane + 64 * jj, head = ci >> 5;
            const f32x4 s0 = *(const f32x4*)(SS + ((size_t)m * 4 + head) * 8), s1 = *(const f32x4*)(SS + ((size_t)m * 4 + head) * 8 + 4);
            const float r = rsqrtf(((s0.x + s0.y) + (s0.z + s0.w) + (s1.x + s1.y) + (s1.z + s1.w)) * (1.f / 256.f) + EPS);
            const v4u ht = __builtin_nontemporal_load((const v4u*)(HT + (size_t)m * 1024 + ci * 8)), mo = __builtin_nontemporal_load((const v4u*)(Z1 + (size_t)m * NZ1 + 3584 + ci * 8));
            const f32x4 g0 = *(const f32x4*)(mg + ci * 8), g1 = *(const f32x4*)(mg + ci * 8 + 4);
            v4u o;
            o.x = cvtpk(sigmf(bflo(mo.x)) * bflo(ht.x) * r * g0.x, sigmf(bfhi(mo.x)) * bfhi(ht.x) * r * g0.y);
            o.y = cvtpk(sigmf(bflo(mo.y)) * bflo(ht.y) * r * g0.z, sigmf(bfhi(mo.y)) * bfhi(ht.y) * r * g0.w);
            o.z = cvtpk(sigmf(bflo(mo.z)) * bflo(ht.z) * r * g1.x, sigmf(bfhi(mo.z)) * bfhi(ht.z) * r * g1.y);
            o.w = cvtpk(sigmf(bflo(mo.w)) * bflo(ht.w) * r * g1.z, sigmf(bfhi(mo.w)) * bfhi(ht.w) * r * g1.w);
            *(v4u*)(HT + (size_t)m * 1024 + ci * 8) = o; }
    }
}

#ifndef PROBE_DUP
#define PROBE_DUP 0
#endif
#ifndef STAGGER_TICKS
#define STAGGER_TICKS 900
#endif
#ifndef PG8_ALIGNV
#define PG8_ALIGNV true
#endif
#ifndef PG8_SP2V
#define PG8_SP2V true
#endif
#ifndef USE_CG_ALL
#define USE_CG_ALL 0
#endif
struct Args { const float* in[23]; float* out; unsigned char* ws; };
enum { I_X = 0, I_F1PRE, I_F1WG, I_F1WU, I_F1WD, I_F1POST, I_MIXPRE, I_WIN, I_CONVW, I_CONVB, I_SINKS, I_BI, I_BF, I_MHG, I_WA, I_WM, I_WO, I_MIXPOST, I_F2PRE, I_F2WG, I_F2WU, I_F2WD, I_F2POST };

__global__ void __launch_bounds__(NWAVES * 64, 2) hybrid_fwd(Args args) {
    extern __shared__ __attribute__((aligned(16))) unsigned char lds_raw[];
    cg::grid_group grid = cg::this_grid();
    LAS unsigned char* lds = (LAS unsigned char*)lds_raw;
    volatile LAS unsigned* MISC = (volatile LAS unsigned*)(lds + MISC_OFF);
    const int wave = __builtin_amdgcn_readfirstlane((int)threadIdx.x >> 6);
#define lane (cur_lane())
#define tid (wave * 64 + cur_lane())
    const int G = gridDim.x, bx = blockIdx.x;
    const int vcu = (G % 8 == 0) ? (bx % 8) * (G / 8) + bx / 8 : bx;
    const int gw = vcu * NWAVES + wave, NGW = G * NWAVES;
    unsigned char* ws = args.ws; unsigned char* ob = (unsigned char*)args.out;
    for (int u = tid; u < (LDS_BYTES - LDS_CTRL) / 4; u += NWAVES * 64) ((LAS unsigned*)(lds + LDS_CTRL))[u] = 0u;
    __syncthreads();
#if !USE_CG_ALL
    if (bx == 0) for (int u = tid; u < XCD_BAR_WORDS; u += NWAVES * 64) ((unsigned*)(ws + WS_CTL))[u] = 0u;
    XcdBarrier bar; bar.bar = (unsigned*)(ws + WS_CTL); bar.x = 0; bar.st = MISC + 8;
#endif

#if USE_CG_ALL
#define SEAM(first) grid.sync()
#else
#define SEAM(first) do { if (first) { grid.sync(); bar = xcd_barrier_post((unsigned*)(ws + WS_CTL), MISC + 8); } else xcd_barrier(bar); } while (0)
#endif
#define GEMM_PHASE(MODE, PAIR, Aptr, Bptr, Kk, Nn, Optr, LDC, O2ptr, GTptr) GEMM_PHASE_W(MODE, PAIR, Aptr, Bptr, Kk, Nn, Optr, LDC, O2ptr, GTptr, 8)
#define GEMM_PHASE_W(MODE, PAIR, Aptr, Bptr, Kk, Nn, Optr, LDC, O2ptr, GTptr, WG) do { \
        pg8::Gemm g_; g_.A = (const bf16*)(Aptr); g_.Bt = (const bf16*)(Bptr); g_.M = M; g_.N = (Nn); g_.K = (Kk); \
        pg8::GenSched<PAIR> S_; S_.so.init(M, (Nn), G, bx); S_.so.wgm = (WG); \
        pg8::GenEpi<MODE> E_; E_.O = (bf16*)(Optr); E_.ldc = (LDC); E_.O2 = (bf16*)(O2ptr); E_.Gt = (const bf16*)(GTptr); \
        pg8::gemm_phase<pg8::GenEpi<MODE>, pg8::GenSched<PAIR>, PG8_ALIGNV, PG8_SP2V>(lds, g_, S_, E_, wave); } while (0)

    {
        P0Ptrs P; P.f1g = args.in[I_F1WG]; P.f1u = args.in[I_F1WU]; P.f1d = args.in[I_F1WD]; P.win = args.in[I_WIN]; P.wa = args.in[I_WA]; P.wm = args.in[I_WM]; P.wo = args.in[I_WO];
        P.f2g = args.in[I_F2WG]; P.f2u = args.in[I_F2WU]; P.f2d = args.in[I_F2WD]; P.g1 = args.in[I_F1PRE]; P.g2 = args.in[I_MIXPRE]; P.g3 = args.in[I_F2PRE];
        P.F1GU = (bf16*)(ob + OUT_F1GU); P.F1D = (bf16*)(ob + OUT_F1D); P.WIN = (bf16*)(ws + WS_WIN); P.WUP = (bf16*)(ws + WS_WUP); P.WOUT = (bf16*)(ws + WS_WOUT); P.F2GU = (bf16*)(ws + WS_F2GU); P.F2D = (bf16*)(ws + WS_F2D);
        p0_xn(args.in[I_X], (bf16*)(ws + WS_XA), (float*)(ws + WS_RS), gw, NGW, lane);
        p0_weights(P, lds, gw, NGW, wave, lane);
#if PROBE_DUP == 1
        __syncthreads(); p0_xn(args.in[I_X], (bf16*)(ws + WS_XA), (float*)(ws + WS_RS), gw, NGW, lane);
        p0_weights(P, lds, gw, NGW, wave, lane);
#endif
    }
    SEAM(1);
    for (int rep = 0; rep < (PROBE_DUP == 5 ? 2 : 1); ++rep)
    GEMM_PHASE(1, 0, ws + WS_XA, ob + OUT_F1GU, D, 2 * FF, ws + WS_H, FF, nullptr, nullptr);
    SEAM(0);
    for (int rep = 0; rep < (PROBE_DUP == 6 ? 2 : 1); ++rep)
    GEMM_PHASE_W(0, 0, ws + WS_H, ob + OUT_F1D, FF, D, ws + WS_F, D, nullptr, nullptr, 4);
    SEAM(0);
    row_phase<false, true>((const bf16*)(ws + WS_F), (const bf16*)(ws + WS_XA), (const float*)(ws + WS_RS), args.out, (float*)(ws + WS_RS) + M, 0.5f, args.in[I_F1POST], args.in[I_MIXPRE], args.in[I_WIN], (float*)(ws + WS_G), lds, gw, NGW, tid, lane);
#if PROBE_DUP == 4
    __syncthreads(); row_phase<false, true>((const bf16*)(ws + WS_F), (const bf16*)(ws + WS_XA), (const float*)(ws + WS_RS), args.out, (float*)(ws + WS_RS) + M, 0.5f, args.in[I_F1POST], args.in[I_MIXPRE], args.in[I_WIN], (float*)(ws + WS_G), lds, gw, NGW, tid, lane);
#endif
    SEAM(0);
    GEMM_PHASE(2, 0, ob, ws + WS_WIN, D, NZ, ws + WS_Z1, NZ1, ws + WS_Z2, nullptr);
    SEAM(0);
    for (int rep = 0; rep < (PROBE_DUP == 2 ? 2 : 1); ++rep)
    for (int u = vcu; u < 512; u += G) attn_unit(lds, (const bf16*)(ws + WS_Z1), (bf16*)(ws + WS_XA), args.in[I_SINKS], u, tid);
    conv_prepass((const bf16*)(ws + WS_Z1), args.in[I_CONVW], args.in[I_CONVB], (bf16*)(ob + 64 * MiB), vcu * (NWAVES * 64) + tid, G * NWAVES * 64);
    SEAM(0);
    for (int rep = 0; rep < (PROBE_DUP == 3 ? 2 : 1); ++rep)
    for (int it = vcu; it < 256; it += G) { mlstm_item(lds, (const bf16*)(ws + WS_Z1), (const bf16*)(ob + 64 * MiB), (const float*)(ws + WS_G), args.in[I_BI], args.in[I_BF], (bf16*)(ws + WS_XA) + (size_t)M * 1024, (float*)(ws + WS_SS), it, tid); __syncthreads(); }
    SEAM(0);
    headnorm_phase((bf16*)(ws + WS_XA) + (size_t)M * 1024, (const float*)(ws + WS_SS), (const bf16*)(ws + WS_Z1), args.in[I_MHG], gw, NGW, lane);
    SEAM(0);
    for (int rep = 0; rep < (PROBE_DUP == 7 ? 2 : 1); ++rep)
    GEMM_PHASE_W(3, 1, ws + WS_XA, ws + WS_WUP, 1024, D, ws + WS_Y, D, nullptr, ws + WS_Z2, 4);
    SEAM(0);
    for (int rep = 0; rep < (PROBE_DUP == 8 ? 2 : 1); ++rep)
    GEMM_PHASE_W(0, 0, ws + WS_Y, ws + WS_WOUT, D, D, ob + 64 * MiB, D, nullptr, nullptr, 4);
    SEAM(0);
    row_phase<false, false>((const bf16*)(ob + 64 * MiB), (const bf16*)ob, (const float*)(ws + WS_RS) + M, ws + WS_H2, (float*)(ws + WS_RS) + 2 * M, 1.0f, args.in[I_MIXPOST], nullptr, nullptr, nullptr, lds, gw, NGW, tid, lane);
    SEAM(0);
    GEMM_PHASE(1, 0, ws + WS_H2, ws + WS_F2GU, D, 2 * FF, ws + WS_H, FF, nullptr, nullptr);
    SEAM(0);
    GEMM_PHASE_W(0, 0, ws + WS_H, ws + WS_F2D, FF, D, ws + WS_XA, D, nullptr, nullptr, 4);
    SEAM(0);
    row_phase<true, false>((const bf16*)(ws + WS_XA), (const bf16*)(ws + WS_H2), (const float*)(ws + WS_RS) + 2 * M, args.out, nullptr, 0.5f, args.in[I_F2POST], nullptr, nullptr, nullptr, lds, gw, NGW, tid, lane);
}
#undef lane
#undef tid

extern "C" void kernel_launch(void* const* d_in, const int* in_sizes, int n_in, void* d_out, int out_size, void* d_ws, size_t ws_size, hipStream_t stream) {
    static int grid = 0;
    if (grid == 0) {
        if (n_in != 23 || in_sizes[0] != M * D || out_size != M * D || ws_size < WS_END) { fprintf(stderr, "kernel_launch: unexpected shapes (n_in %d, in0 %d, out %d, ws %zu, need %zu)\n", n_in, n_in > 0 ? in_sizes[0] : -1, out_size, ws_size, (size_t)WS_END); grid = -1; return; }
        int dev = 0, cus = 0, per_cu = 0;
        if (hipGetDevice(&dev) != hipSuccess || hipDeviceGetAttribute(&cus, hipDeviceAttributeMultiprocessorCount, dev) != hipSuccess) { grid = -1; return; }
        if (hipFuncSetAttribute((const void*)hybrid_fwd, hipFuncAttributeMaxDynamicSharedMemorySize, LDS_BYTES) != hipSuccess) { fprintf(stderr, "kernel_launch: hipFuncSetAttribute failed\n"); grid = -1; return; }
        if (hipOccupancyMaxActiveBlocksPerMultiprocessor(&per_cu, (const void*)hybrid_fwd, NWAVES * 64, LDS_BYTES) != hipSuccess || per_cu < 1) { fprintf(stderr, "kernel_launch: occupancy query says %d\n", per_cu); per_cu = 1; }
        (void)hipGetLastError();
        grid = cus * per_cu;
    }
    if (grid < 0) return;
    Args a{};
    for (int i = 0; i < 23; ++i) a.in[i] = (const float*)d_in[i];
    a.out = (float*)d_out; a.ws = (unsigned char*)d_ws;
    void* kargs[] = {&a};
    hipError_t e = hipLaunchCooperativeKernel((const void*)hybrid_fwd, dim3(grid), dim3(NWAVES * 64), kargs, LDS_BYTES, stream);
    if (e != hipSuccess) fprintf(stderr, "kernel_launch: cooperative launch failed: %s (grid %d)\n", hipGetErrorString(e), grid);
}
```

```cpp
#include <hip/hip_runtime.h>
#include <hip/hip_cooperative_groups.h>
#include <cstdio>
#include <cstdint>
namespace cg = cooperative_groups;
namespace pg8 {
#define PG8_LAS __attribute__((address_space(3)))
typedef unsigned short bf16_t;
typedef short bf16x8 __attribute__((ext_vector_type(8)));
typedef float f32x4 __attribute__((ext_vector_type(4)));
typedef unsigned u32x4 __attribute__((ext_vector_type(4)));
constexpr int BM = 256, BK = 64, HALF = 128, HTB = HALF * BK * 2  , STAGE_BYTES = 8 * HTB, NXCD = 8, WGM = 8;

__host__ __device__ __forceinline__ int lds_byte(int r, int c) { const int st = (r >> 4) * 2 + (c >> 5), rr = r & 15, cc = c & 31, ob = rr * 64 + cc * 2; return st * 1024 + (ob ^ (((ob >> 9) & 1) << 5)); }
__host__ __device__ __forceinline__ void stage_rc(int b, int& R, int& C) { const int st = b / 1024, sb = b % 1024, swz = sb ^ (((sb >> 9) & 1) << 5); R = (st >> 1) * 16 + swz / 64; C = (st & 1) * 32 + (swz % 64) / 2; }
__host__ __device__ __forceinline__ int perm32(int rho) { const int n = rho >> 4, i = rho & 15; return 8 * (i >> 2) + 4 * n + (i & 3); }

struct Unit { int pm, pn; };
struct Gemm { const bf16_t* A; const bf16_t* Bt; int M, N, K; };

struct StaticOrder {
    int nM, nN, nwg, G, c, wgm;
    __host__ __device__ void init(int M, int N, int G_, int c_) { nM = M / BM; nN = N / BM; nwg = nM * nN; G = G_; c = c_; wgm = WGM; }
    __host__ __device__ bool next(int i, Unit& u) const {
        const long L = (long)i * G + c; if (L >= nwg) return false;
        int wgid = (int)L; { const int q = nwg / NXCD, r = nwg % NXCD, xcd = wgid % NXCD, off = wgid / NXCD; wgid = (xcd < r ? xcd * (q + 1) : r * (q + 1) + (xcd - r) * q) + off; }
        const int nig = wgm * nN, gid = wgid / nig, fm = gid * wgm, gsz = (nM - fm) < wgm ? (nM - fm) : wgm;
        u.pm = fm + ((wgid % nig) % gsz); u.pn = (wgid % nig) / gsz; return true;
    }
    __device__ __forceinline__ void a_ready(const Unit&) const {}
    __device__ __forceinline__ void done(const Unit&) const {}
};

__device__ __forceinline__ unsigned cvt_pk_bf16(float lo, float hi) { unsigned r; asm volatile("v_cvt_pk_bf16_f32 %0, %1, %2" : "=v"(r) : "v"(lo), "v"(hi)); return r; }
template <int PAIR> struct GenSched {
    StaticOrder so; static constexpr int pair = PAIR;
    __device__ __forceinline__ bool next(int i, Unit& u) const {
        if (pair) { Unit t; if (!so.next(i >> 1, t)) return false; const int part = i & 1; u.pm = t.pm + part * 64; u.pn = t.pn + part * 8; return true; }
        return so.next(i, u);
    }
    __device__ __forceinline__ void a_ready(const Unit&) const {}
    __device__ __forceinline__ void done(const Unit&) const {}
};
__device__ __forceinline__ float bflo(unsigned w) { return __builtin_bit_cast(float, w << 16); }
__device__ __forceinline__ float bfhi(unsigned w) { return __builtin_bit_cast(float, w & 0xffff0000u); }
__device__ __forceinline__ float sigm(float x) { return __builtin_amdgcn_rcpf(1.0f + __builtin_amdgcn_exp2f(x * -1.44269504089f)); }
template <int MODE> struct GenEpi {
    static constexpr bool PERM = true, AFTER_DRAIN = false; static constexpr int mode = MODE;
    bf16_t* O; int ldc; bf16_t* O2; const bf16_t* Gt;
    __device__ __forceinline__ void operator()(const f32x4 (&acc)[2][2][4][2], const Unit& u, int wr, int wc, int fr, int fq) const {
        if constexpr (MODE == 1) {
            const int row0 = u.pm * BM + wr * 64 + fr, col0 = u.pn * 128 + wc * 32 + 8 * fq;
#pragma unroll
            for (int ai = 0; ai < 2; ++ai)
#pragma unroll
                for (int m = 0; m < 4; ++m) { bf16_t* rowp = O + (size_t)(row0 + ai * HALF + m * 16) * ldc + col0;
                    f32x4 g0 = acc[ai][0][m][0], g1 = acc[ai][0][m][1], u0 = acc[ai][1][m][0], u1 = acc[ai][1][m][1], h0, h1;
#pragma unroll
                    for (int j = 0; j < 4; ++j) { h0[j] = g0[j] * u0[j] * sigm(g0[j]); h1[j] = g1[j] * u1[j] * sigm(g1[j]); }
                    u32x4 w; w.x = cvt_pk_bf16(h0[0], h0[1]); w.y = cvt_pk_bf16(h0[2], h0[3]); w.z = cvt_pk_bf16(h1[0], h1[1]); w.w = cvt_pk_bf16(h1[2], h1[3]);
                    *(u32x4*)rowp = w; }
        } else if constexpr (MODE == 3) {
            const int part = u.pn >> 3, pn = u.pn & 7, pm = u.pm & 63;
            const int row0 = pm * BM + wr * 64 + fr, col0 = pn * BM + wc * 32 + 8 * fq;
#pragma unroll
            for (int ai = 0; ai < 2; ++ai) {
                u32x4 gt[4][2], yo[4][2];
#pragma unroll
                for (int m = 0; m < 4; ++m)
#pragma unroll
                    for (int bj = 0; bj < 2; ++bj) gt[m][bj] = *(const u32x4*)(Gt + (size_t)(row0 + ai * HALF + m * 16) * 4096 + part * 2048 + col0 + bj * HALF);
                if (part) {
#pragma unroll
                    for (int m = 0; m < 4; ++m)
#pragma unroll
                        for (int bj = 0; bj < 2; ++bj) yo[m][bj] = *(const u32x4*)(O + (size_t)(row0 + ai * HALF + m * 16) * 2048 + col0 + bj * HALF);
                } else {
#pragma unroll
                    for (int m = 0; m < 4; ++m)
#pragma unroll
                        for (int bj = 0; bj < 2; ++bj) yo[m][bj] = (u32x4){0u, 0u, 0u, 0u};
                }
#pragma unroll
                for (int m = 0; m < 4; ++m)
#pragma unroll
                    for (int bj = 0; bj < 2; ++bj) { const u32x4 g4 = gt[m][bj], y4 = yo[m][bj]; const f32x4 v0 = acc[ai][bj][m][0], v1 = acc[ai][bj][m][1];
                        float r[8];
                        r[0] = bflo(y4.x) + v0[0] * sigm(bflo(g4.x)); r[1] = bfhi(y4.x) + v0[1] * sigm(bfhi(g4.x)); r[2] = bflo(y4.y) + v0[2] * sigm(bflo(g4.y)); r[3] = bfhi(y4.y) + v0[3] * sigm(bfhi(g4.y));
                        r[4] = bflo(y4.z) + v1[0] * sigm(bflo(g4.z)); r[5] = bfhi(y4.z) + v1[1] * sigm(bfhi(g4.z)); r[6] = bflo(y4.w) + v1[2] * sigm(bflo(g4.w)); r[7] = bfhi(y4.w) + v1[3] * sigm(bfhi(g4.w));
                        u32x4 w; w.x = cvt_pk_bf16(r[0], r[1]); w.y = cvt_pk_bf16(r[2], r[3]); w.z = cvt_pk_bf16(r[4], r[5]); w.w = cvt_pk_bf16(r[6], r[7]);
                        *(u32x4*)(O + (size_t)(row0 + ai * HALF + m * 16) * 2048 + col0 + bj * HALF) = w; }
            }
        } else if (mode == 2 && u.pn * BM >= 8704) {
            if (wc == 0 && fq == 0) { float* Gf = (float*)Gt; const int row0 = u.pm * BM + wr * 64 + fr;
#pragma unroll
                for (int ai = 0; ai < 2; ++ai)
#pragma unroll
                    for (int m = 0; m < 4; ++m) { float* gp = Gf + (size_t)(row0 + ai * HALF + m * 16) * 8; *(f32x4*)gp = acc[ai][0][m][0]; *(f32x4*)(gp + 4) = acc[ai][0][m][1]; } }
        } else {
            int colt = u.pn * BM; bf16_t* base = O; int ld = ldc;
            if (mode == 2 && colt >= 4608) { base = O2; ld = 4096; colt -= 4608; }
            const int row0 = u.pm * BM + wr * 64 + fr, col0 = colt + wc * 32 + 8 * fq;
#pragma unroll
            for (int ai = 0; ai < 2; ++ai)
#pragma unroll
                for (int m = 0; m < 4; ++m) { bf16_t* rowp = base + (size_t)(row0 + ai * HALF + m * 16) * ld + col0;
#pragma unroll
                    for (int bj = 0; bj < 2; ++bj) { const f32x4 v0 = acc[ai][bj][m][0], v1 = acc[ai][bj][m][1];
                        u32x4 w; w.x = cvt_pk_bf16(v0[0], v0[1]); w.y = cvt_pk_bf16(v0[2], v0[3]); w.z = cvt_pk_bf16(v1[0], v1[1]); w.w = cvt_pk_bf16(v1[2], v1[3]);
                        *(u32x4*)(rowp + bj * HALF) = w; } }
        }
    }
};

template <class Epi, class Sched, bool ALIGN_EPI = false, bool SP2 = false>
__device__ __forceinline__ void gemm_phase(PG8_LAS unsigned char* lds, const Gemm g, const Sched& S, const Epi& E, const int wid) {
    int lane; asm volatile("v_mbcnt_lo_u32_b32 %0, -1, 0\n\tv_mbcnt_hi_u32_b32 %0, -1, %0" : "=v"(lane));
    const int tid = wid * 64 + lane, wr = wid >> 2, wc = wid & 3, fr = lane & 15, fq = lane >> 4;
    const int K = g.K, nt = K / BK;
    unsigned voffA[2], voffB[2];
#pragma unroll
    for (int i = 0; i < 2; ++i) { int R, C; stage_rc(tid * 16 + i * 8192, R, C); const int Rb = Epi::PERM ? ((R & ~31) + perm32(R & 31)) : R;
        voffA[i] = (unsigned)(R * K + C) * 2u; voffB[i] = (unsigned)(Rb * K + C) * 2u; }
    const size_t kstep = (size_t)(BK * 2);
    const size_t hstep = (size_t)HALF * K * 2;
    const size_t tstep = 2 * hstep;
    const unsigned ldsw = (unsigned)wid * 1024u;
    const int aoff = lds_byte(wr * 64 + fr, fq * 8), boff = lds_byte(wc * 32 + fr, fq * 8);
#define PG8_SA(b, h) (((b) * 2 + (h)) * HTB)
#define PG8_SB(b, h) ((4 + (b) * 2 + (h)) * HTB)
#define PG8_STAGE(bufoff, gbase, voff) do { _Pragma("unroll") for (int _i = 0; _i < 2; ++_i) \
        __builtin_amdgcn_global_load_lds((const unsigned*)((const char*)(gbase) + (voff)[_i]), (PG8_LAS unsigned*)(lds + (bufoff) + ldsw + _i * 8192), 16, 0, 0); } while (0)
#define PG8_LDA(dst, b, h) do { _Pragma("unroll") for (int m = 0; m < 4; ++m) _Pragma("unroll") for (int k = 0; k < 2; ++k) dst[m][k] = *(const PG8_LAS bf16x8*)(lds + PG8_SA(b, h) + aoff + m * 2048 + k * 1024); } while (0)
#define PG8_LDB(dst, b, h) do { _Pragma("unroll") for (int n = 0; n < 2; ++n) _Pragma("unroll") for (int k = 0; k < 2; ++k) dst[n][k] = *(const PG8_LAS bf16x8*)(lds + PG8_SB(b, h) + boff + n * 2048 + k * 1024); } while (0)
#define PG8_MMA(ai, bj, At, Bt) do { __builtin_amdgcn_s_setprio(1); _Pragma("unroll") for (int m = 0; m < 4; ++m) _Pragma("unroll") for (int n = 0; n < 2; ++n) _Pragma("unroll") for (int k = 0; k < 2; ++k) \
        acc[ai][bj][m][n] = __builtin_amdgcn_mfma_f32_16x16x32_bf16(Bt[n][k], At[m][k], acc[ai][bj][m][n], 0, 0, 0); __builtin_amdgcn_s_setprio(0); } while (0)
#define PG8_WAIT_V(n) asm volatile("s_waitcnt vmcnt(" #n ")" ::: "memory")
#define PG8_WAIT_L(n) asm volatile("s_waitcnt lgkmcnt(" #n ")" ::: "memory")
#define PG8_BAR __builtin_amdgcn_s_barrier()
#define PG8_SCHED __builtin_amdgcn_sched_barrier(0)
    Unit cur, nxt; int ui = 0;
    if (!S.next(0, cur)) return;
    f32x4 acc[2][2][4][2];
#pragma unroll
    for (int a = 0; a < 2; ++a)
#pragma unroll
        for (int b = 0; b < 2; ++b)
#pragma unroll
            for (int m = 0; m < 4; ++m)
#pragma unroll
                for (int n = 0; n < 2; ++n) acc[a][b][m][n] = (f32x4){0.f, 0.f, 0.f, 0.f};
    bf16x8 At[4][2], B0[2][2], B1[2][2];
    const char* cA = (const char*)g.A + (size_t)cur.pm * tstep; const char* cB = (const char*)g.Bt + (size_t)cur.pn * tstep;
    S.a_ready(cur);
    if constexpr (SP2) {
        PG8_STAGE(PG8_SB(0, 0), cB, voffB); PG8_STAGE(PG8_SB(0, 1), cB + hstep, voffB); PG8_STAGE(PG8_SA(0, 0), cA, voffA); PG8_STAGE(PG8_SA(0, 1), cA + hstep, voffA);
        if (wr == 1) PG8_BAR;
        PG8_WAIT_V(2); PG8_BAR;
        PG8_STAGE(PG8_SB(1, 0), cB + kstep, voffB); PG8_STAGE(PG8_SA(1, 0), cA + kstep, voffA); PG8_STAGE(PG8_SB(1, 1), cB + hstep + kstep, voffB);
        PG8_WAIT_V(6); PG8_BAR;
    } else {
        PG8_STAGE(PG8_SB(0, 0), cB, voffB); PG8_STAGE(PG8_SA(0, 0), cA, voffA); PG8_STAGE(PG8_SB(0, 1), cB + hstep, voffB); PG8_STAGE(PG8_SA(0, 1), cA + hstep, voffA);
        if (wr == 1) PG8_BAR;
        PG8_WAIT_V(4); PG8_BAR;
        PG8_STAGE(PG8_SB(1, 0), cB + kstep, voffB); PG8_STAGE(PG8_SA(1, 0), cA + kstep, voffA); PG8_STAGE(PG8_SB(1, 1), cB + hstep + kstep, voffB);
        PG8_WAIT_V(6); PG8_BAR;
    }
    for (;;) {
        const bool has_next = S.next(ui + 1, nxt);
        const char* nA = has_next ? (const char*)g.A + (size_t)nxt.pm * tstep : cA; const char* nB = has_next ? (const char*)g.Bt + (size_t)nxt.pn * tstep : cB;
        for (int t = 0; t < nt; t += 2) {
            const bool last = (t == nt - 2);
            const char* a1 = cA + (size_t)(t + 1) * kstep;
            const char* a2 = last ? nA : cA + (size_t)(t + 2) * kstep; const char* b2 = last ? nB : cB + (size_t)(t + 2) * kstep;
            const char* a3 = a2 + kstep; const char* b3 = b2 + kstep;
            if (last && has_next) S.a_ready(nxt);
            if constexpr (SP2) {
            PG8_LDB(B0, 0, 0); PG8_LDB(B1, 0, 1); PG8_SCHED; PG8_LDA(At, 0, 0); PG8_STAGE(PG8_SA(1, 1), a1 + hstep, voffA);
            PG8_WAIT_V(8); PG8_WAIT_L(0); PG8_BAR; PG8_MMA(0, 0, At, B0); PG8_MMA(0, 1, At, B1); PG8_BAR; PG8_SCHED;
            PG8_LDA(At, 0, 1); PG8_STAGE(PG8_SB(0, 0), b2, voffB); PG8_STAGE(PG8_SB(0, 1), b2 + hstep, voffB); PG8_STAGE(PG8_SA(0, 0), a2, voffA);
            PG8_WAIT_V(8); PG8_WAIT_L(0); PG8_BAR; PG8_MMA(1, 0, At, B0); PG8_MMA(1, 1, At, B1); PG8_BAR; PG8_SCHED;
            PG8_LDB(B0, 1, 0); PG8_LDB(B1, 1, 1); PG8_SCHED; PG8_LDA(At, 1, 0); PG8_STAGE(PG8_SA(0, 1), a2 + hstep, voffA);
            PG8_WAIT_V(8); PG8_WAIT_L(0); PG8_BAR; PG8_MMA(0, 0, At, B0); PG8_MMA(0, 1, At, B1); PG8_BAR; PG8_SCHED;
            PG8_LDA(At, 1, 1); PG8_STAGE(PG8_SB(1, 0), b3, voffB); PG8_STAGE(PG8_SB(1, 1), b3 + hstep, voffB); PG8_STAGE(PG8_SA(1, 0), a3, voffA);
            PG8_WAIT_V(8); PG8_WAIT_L(0); PG8_BAR; PG8_MMA(1, 0, At, B0); PG8_MMA(1, 1, At, B1); PG8_BAR; PG8_SCHED;
            } else {
            PG8_LDB(B0, 0, 0); PG8_SCHED; PG8_LDA(At, 0, 0); PG8_STAGE(PG8_SA(1, 1), a1 + hstep, voffA);
            PG8_WAIT_L(8); PG8_BAR; PG8_WAIT_L(0); PG8_MMA(0, 0, At, B0); PG8_BAR; PG8_SCHED;
            PG8_LDB(B1, 0, 1); PG8_STAGE(PG8_SB(0, 0), b2, voffB);
            PG8_BAR; PG8_WAIT_L(0); PG8_MMA(0, 1, At, B1); PG8_BAR;
            PG8_LDA(At, 0, 1); PG8_STAGE(PG8_SA(0, 0), a2, voffA);
            PG8_BAR; PG8_WAIT_L(0); PG8_MMA(1, 0, At, B0); PG8_BAR; PG8_SCHED;
            PG8_STAGE(PG8_SB(0, 1), b2 + hstep, voffB);
            PG8_WAIT_V(6); PG8_BAR; PG8_MMA(1, 1, At, B1); PG8_BAR;
            PG8_LDB(B0, 1, 0); PG8_SCHED; PG8_LDA(At, 1, 0); PG8_STAGE(PG8_SA(0, 1), a2 + hstep, voffA);
            PG8_WAIT_L(8); PG8_BAR; PG8_WAIT_L(0); PG8_MMA(0, 0, At, B0); PG8_BAR; PG8_SCHED;
            PG8_LDB(B1, 1, 1); PG8_STAGE(PG8_SB(1, 0), b3, voffB);
            PG8_BAR; PG8_WAIT_L(0); PG8_MMA(0, 1, At, B1); PG8_BAR;
            PG8_LDA(At, 1, 1); PG8_STAGE(PG8_SA(1, 0), a3, voffA);
            PG8_BAR; PG8_WAIT_L(0); PG8_MMA(1, 0, At, B0); PG8_BAR; PG8_SCHED;
            PG8_STAGE(PG8_SB(1, 1), b3 + hstep, voffB);
            PG8_WAIT_V(6); PG8_BAR; PG8_MMA(1, 1, At, B1); PG8_BAR;
            }
        }
        if constexpr (ALIGN_EPI) { if (wr == 0) PG8_BAR; }
        if constexpr (!Epi::AFTER_DRAIN) { E(acc, cur, wr, wc, fr, fq); S.done(cur); }
        if (!has_next) break;
#pragma unroll
        for (int a = 0; a < 2; ++a)
#pragma unroll
            for (int b = 0; b < 2; ++b)
#pragma unroll
                for (int m = 0; m < 4; ++m)
#pragma unroll
                    for (int n = 0; n < 2; ++n) acc[a][b][m][n] = (f32x4){0.f, 0.f, 0.f, 0.f};
        cur = nxt; cA = nA; cB = nB; ++ui;
        if constexpr (ALIGN_EPI) { if (wr == 1) PG8_BAR; }
    }
    PG8_WAIT_V(0);
    if constexpr (!ALIGN_EPI) { if (wr == 0) PG8_BAR; }
    PG8_BAR;
    if constexpr (Epi::AFTER_DRAIN) { E.fused(acc, cur, wr, wc, fr, fq, lds, wid, lane); S.done(cur); }
#undef PG8_SA
#undef PG8_SB
#undef PG8_STAGE
#undef PG8_LDA
#undef PG8_LDB
#undef PG8_MMA
#undef PG8_WAIT_V
#undef PG8_WAIT_L
#undef PG8_BAR
#undef PG8_SCHED
}
}
#define GAS __attribute__((address_space(1)))
#define LAS __attribute__((address_space(3)))
typedef unsigned short bf16;
typedef unsigned v4u __attribute__((ext_vector_type(4)));
typedef float f32x4 __attribute__((ext_vector_type(4)));
typedef short bf16x8 __attribute__((ext_vector_type(8)));
typedef GAS unsigned gu32;
typedef GAS unsigned long long gu64;
#define RLX_AGENT __ATOMIC_RELAXED, __HIP_MEMORY_SCOPE_AGENT
#define LDS_WAIT() asm volatile("s_waitcnt lgkmcnt(0)" ::: "memory")
#define VM_WAIT() asm volatile("s_waitcnt vmcnt(0)" ::: "memory")
__device__ __forceinline__ unsigned long long rt() { return __builtin_amdgcn_s_memrealtime(); }
__device__ __forceinline__ unsigned f2bf(float f) { unsigned u = __builtin_bit_cast(unsigned, f); return (u + 0x7fffu + ((u >> 16) & 1u)) >> 16; }
__device__ __forceinline__ unsigned pk2(float lo, float hi) { return f2bf(lo) | (f2bf(hi) << 16); }

#define XB_TMO      128
#define XB_XCNT(j)  (256  + 64 * (j))
#define XB_XSUB(j)  (1280 + 64 * (j))
#define XB_XGEN(j)  (2304 + 64 * (j))
#define XB_TOP      3328
#define XB_TOPGEN   3392
#define XCD_BAR_WORDS 3456
#define XB_SPIN_CAP (1u << 18)

__device__ __forceinline__ unsigned xb_ld(unsigned* p)              { return __hip_atomic_load(p, __ATOMIC_RELAXED, __HIP_MEMORY_SCOPE_AGENT); }
__device__ __forceinline__ unsigned xb_add(unsigned* p, unsigned v) { return __hip_atomic_fetch_add(p, v, __ATOMIC_RELAXED, __HIP_MEMORY_SCOPE_AGENT); }
__device__ __forceinline__ unsigned xb_xcc_id() { return (unsigned)__builtin_amdgcn_s_getreg((3 << 11) | 20) & 0xFu; }
#define XB_SPIN(cond, bar) do { unsigned _sp = 0; while (cond) { __builtin_amdgcn_s_sleep(1); \
    if ((++_sp & 255u) == 0u) { if (xb_ld(&(bar)[XB_TMO])) break; if (_sp > XB_SPIN_CAP) { atomicAdd(&(bar)[XB_TMO], 1u); break; } } } } while (0)

struct XcdBarrier {
    unsigned* bar; unsigned x;
    volatile LAS unsigned* st;
};

__device__ __forceinline__ XcdBarrier xcd_barrier_post(unsigned* bar, volatile LAS unsigned* st) {
    XcdBarrier b; b.bar = bar; b.x = xb_xcc_id(); b.st = st;
    if (threadIdx.x == 0) (void)xb_add(&bar[XB_XCNT(b.x)], 1u);
    return b;
}
__device__ __forceinline__ void xcd_barrier_complete(unsigned* bar, unsigned x, unsigned& nloc, unsigned& nx) {
    const unsigned G = gridDim.x * gridDim.y * gridDim.z;
    unsigned sum, cnt, mine, sp = 0u;
    for (;;) {
        sum = 0u; cnt = 0u; mine = 0u;
#pragma unroll
        for (unsigned j = 0; j < 16; ++j) { const unsigned c = xb_ld(&bar[XB_XCNT(j)]); sum += c; cnt += (c > 0u) ? 1u : 0u; mine = (j == x) ? c : mine; }
        if (sum == G) break;
        __builtin_amdgcn_s_sleep(1);
        if ((++sp & 255u) == 0u) { if (xb_ld(&bar[XB_TMO])) break; if (sp > XB_SPIN_CAP) { atomicAdd(&bar[XB_TMO], 1u); break; } }
    }
    nloc = mine > 0u ? mine : 1u; nx = cnt > 0u ? cnt : 1u;
}

__device__ __forceinline__ void xcd_barrier(const XcdBarrier& b) {
    asm volatile("s_waitcnt vmcnt(0)" ::: "memory");
    __syncthreads();
    if (threadIdx.x == 0) {
        unsigned* bar = b.bar;
        __builtin_amdgcn_s_waitcnt(0);
        unsigned nloc = b.st[0], nx = b.st[1];
        if (nloc == 0u) { xcd_barrier_complete(bar, b.x, nloc, nx); b.st[0] = nloc; b.st[1] = nx; }
        const unsigned old = xb_add(&bar[XB_XSUB(b.x)], 1u);
        const unsigned gen = old / nloc;
        if (old + 1u == (gen + 1u) * nloc) {
            __builtin_amdgcn_fence(__ATOMIC_RELEASE, "agent");
            asm volatile("s_waitcnt vmcnt(0)" ::: "memory");
            const unsigned og = xb_add(&bar[XB_TOP], 1u);
            const unsigned tg = og / nx;
            if (og + 1u == (tg + 1u) * nx) xb_add(&bar[XB_TOPGEN], 1u);
            else XB_SPIN(xb_ld(&bar[XB_TOPGEN]) == tg, bar);
            __builtin_amdgcn_fence(__ATOMIC_ACQUIRE, "agent");
            xb_add(&bar[XB_XGEN(b.x)], 1u);
            asm volatile("s_waitcnt vmcnt(0)" ::: "memory");
        } else {
            XB_SPIN(xb_ld(&bar[XB_XGEN(b.x)]) == gen, bar);
            __builtin_amdgcn_fence(__ATOMIC_ACQUIRE, "agent");
            asm volatile("s_waitcnt vmcnt(0)" ::: "memory");
        }
    }
    __syncthreads();
}

__device__ __forceinline__ int cur_lane() { int l; asm volatile("v_mbcnt_lo_u32_b32 %0, -1, 0\n\tv_mbcnt_hi_u32_b32 %0, -1, %0" : "=v"(l)); return l; }

constexpr int NWAVES = 8;
constexpr int M = 16384, D = 2048, FF = 5632, SEQ = 2048;
constexpr int NZ1 = 4608, NZ2 = 4096, NZ = 8704, DIN = 8712;
constexpr float EPS = 1e-6f;
constexpr size_t MiB = 1u << 20;
constexpr size_t WS_CTL = 0, CTL_ZERO_BYTES = 64 * 1024;
constexpr size_t WS_G = 1 * MiB;
constexpr size_t WS_RS = 1 * MiB + 512 * 1024;
constexpr size_t WS_SS = 2 * MiB;
constexpr size_t WS_WIN_SLOT = 4 * MiB;
constexpr size_t WS_WUP = WS_WIN_SLOT + (size_t)NZ * D * 2;
constexpr size_t WS_WOUT = WS_WUP + (size_t)4096 * 1024 * 2;
constexpr size_t WS_F2GU = WS_WOUT + (size_t)D * D * 2;
constexpr size_t WS_F2D = WS_F2GU + (size_t)2 * FF * D * 2;
constexpr size_t WS_WEND = WS_F2D + (size_t)D * FF * 2;
constexpr size_t WS_XA = 120 * MiB;
constexpr size_t WS_B = 184 * MiB;
constexpr size_t WS_H = WS_B, WS_F = WS_B + 176 * MiB, WS_Z1 = WS_B, WS_Z2 = WS_B + 144 * MiB, WS_Y = WS_B, WS_YO = WS_B + 144 * MiB, WS_H2 = WS_B + 176 * MiB;
constexpr int NZG = NZ + 256;
constexpr size_t WS_WIN = WS_B + 272 * MiB;
constexpr size_t WS_END = WS_WIN + (size_t)NZG * D * 2;
static_assert(WS_WEND <= WS_XA, "weights fit");
static_assert(WS_END <= 512 * MiB, "workspace fits 512 MiB");
constexpr size_t OUT_F1GU = 0, OUT_F1D = (size_t)2 * FF * D * 2;
constexpr int LDS_BYTES = 157696;
constexpr int LDS_CTRL = 156672, MISC_OFF = LDS_CTRL + 320;

typedef unsigned u32x2 __attribute__((ext_vector_type(2)));
__device__ __forceinline__ float bflo(unsigned w) { return __builtin_bit_cast(float, w << 16); }
__device__ __forceinline__ float bfhi(unsigned w) { return __builtin_bit_cast(float, w & 0xffff0000u); }
__device__ __forceinline__ unsigned cvtpk(float lo, float hi) { unsigned r; asm volatile("v_cvt_pk_bf16_f32 %0, %1, %2" : "=v"(r) : "v"(lo), "v"(hi)); return r; }
__device__ __forceinline__ float sigmf(float x) { return __builtin_amdgcn_rcpf(1.0f + __builtin_amdgcn_exp2f(x * -1.44269504089f)); }
#define DPP_ADD(v, ctrl, row_mask) ((v) + __builtin_bit_cast(float, __builtin_amdgcn_update_dpp(0, __builtin_bit_cast(int, (v)), (ctrl), (row_mask), 0xf, false)))
__device__ __forceinline__ float wave_sum(float v) {
    v = DPP_ADD(v, 0x111, 0xf); v = DPP_ADD(v, 0x112, 0xf); v = DPP_ADD(v, 0x114, 0xf); v = DPP_ADD(v, 0x118, 0xf);
    v = DPP_ADD(v, 0x142, 0xa); v = DPP_ADD(v, 0x143, 0xc);
    return __builtin_bit_cast(float, __builtin_amdgcn_readlane(__builtin_bit_cast(int, v), 63));
}
__device__ __forceinline__ f32x4 mfma16(bf16x8 a, bf16x8 b, f32x4 c) { return __builtin_amdgcn_mfma_f32_16x16x32_bf16(a, b, c, 0, 0, 0); }

__device__ __forceinline__ void p0_transpose_item(const float* W, int ldw, int c0, int K, int k0, bf16* WT, int drow0, LAS float* scr, int lane, const float* gvec) {
#pragma unroll 8
    for (int i = 0; i < 32; ++i) { const int kk = 2 * i + (lane >> 5); scr[kk * 33 + (lane & 31)] = __builtin_nontemporal_load(W + (size_t)(k0 + kk) * ldw + c0 + (lane & 31)); }
    LDS_WAIT(); asm volatile("" ::: "memory");
    const int c = lane & 7;
    f32x4 ga = (f32x4){1.f, 1.f, 1.f, 1.f}, gb = ga; if (gvec) { ga = *(const f32x4*)(gvec + k0 + 8 * c); gb = *(const f32x4*)(gvec + k0 + 8 * c + 4); }
#pragma unroll
    for (int j = 0; j < 4; ++j) { const int n = (lane >> 3) + 8 * j; const LAS float* s = scr + (8 * c) * 33 + n;
        v4u o; o.x = cvtpk(s[0 * 33] * ga.x, s[1 * 33] * ga.y); o.y = cvtpk(s[2 * 33] * ga.z, s[3 * 33] * ga.w); o.z = cvtpk(s[4 * 33] * gb.x, s[5 * 33] * gb.y); o.w = cvtpk(s[6 * 33] * gb.z, s[7 * 33] * gb.w);
        *(GAS v4u*)(WT + (size_t)(drow0 + n) * K + k0 + 8 * c) = o; }
    LDS_WAIT(); asm volatile("" ::: "memory");
}
struct P0Ptrs { const float *f1g, *f1u, *f1d, *win, *wa, *wm, *wo, *f2g, *f2u, *f2d, *g1, *g2, *g3; bf16 *F1GU, *F1D, *WIN, *WUP, *WOUT, *F2GU, *F2D; };
__device__ __forceinline__ void p0_weights(const P0Ptrs& P, LAS unsigned char* lds, int gw, int NGW, int wave, int lane) {
    LAS float* scr = (LAS float*)(lds + wave * 16384);
    constexpr int I_GU = 32 * 176, I_D = 88 * 64, I_IN1 = 32 * 144, I_IN2 = 32 * 128, I_UP = 16 * 64, I_O = 32 * 64;
    constexpr int I_G = 32, NITEMS = 2 * (2 * I_GU + I_D) + I_IN1 + I_IN2 + 2 * I_UP + I_O + I_G;
    for (int it = gw; it < NITEMS; it += NGW) {
        int r = it; const float* W; int ldw, c0, K, k0, drow0; bf16* WT; const float* gv = nullptr;
        if (r < 2 * I_GU) { const int up = r >= I_GU; if (up) r -= I_GU; const int kb = r / 176, nb = r % 176; W = up ? P.f1u : P.f1g; gv = P.g1; ldw = FF; c0 = 32 * nb; K = D; k0 = 64 * kb; WT = P.F1GU; drow0 = 256 * (nb >> 2) + 32 * (nb & 3) + (up ? 128 : 0); }
        else if ((r -= 2 * I_GU) < I_D) { const int kb = r / 64, nb = r % 64; W = P.f1d; ldw = D; c0 = 32 * nb; K = FF; k0 = 64 * kb; WT = P.F1D; drow0 = 32 * nb; }
        else if ((r -= I_D) < 2 * I_GU) { const int up = r >= I_GU; if (up) r -= I_GU; const int kb = r / 176, nb = r % 176; W = up ? P.f2u : P.f2g; gv = P.g3; ldw = FF; c0 = 32 * nb; K = D; k0 = 64 * kb; WT = P.F2GU; drow0 = 256 * (nb >> 2) + 32 * (nb & 3) + (up ? 128 : 0); }
        else if ((r -= 2 * I_GU) < I_D) { const int kb = r / 64, nb = r % 64; W = P.f2d; ldw = D; c0 = 32 * nb; K = FF; k0 = 64 * kb; WT = P.F2D; drow0 = 32 * nb; }
        else if ((r -= I_D) < I_IN1) { const int kb = r / 144, nb = r % 144; W = P.win; gv = P.g2; ldw = DIN; c0 = 32 * nb; K = D; k0 = 64 * kb; WT = P.WIN; drow0 = 32 * nb; }
        else if ((r -= I_IN1) < I_IN2) { const int kb = r / 128, nb = r % 128; W = P.win; gv = P.g2; ldw = DIN; c0 = 4616 + 32 * nb; K = D; k0 = 64 * kb; WT = P.WIN; drow0 = 4608 + 32 * nb; }
        else if ((r -= I_IN2) < 2 * I_UP) { const int m2 = r >= I_UP; if (m2) r -= I_UP; const int kb = r / 64, nb = r % 64; W = m2 ? P.wm : P.wa; ldw = D; c0 = 32 * nb; K = 1024; k0 = 64 * kb; WT = P.WUP; drow0 = (m2 ? 2048 : 0) + 32 * nb; }
        else if ((r -= 2 * I_UP) < I_O) { const int kb = r / 64, nb = r % 64; W = P.wo; ldw = D; c0 = 32 * nb; K = D; k0 = 64 * kb; WT = P.WOUT; drow0 = 32 * nb; }
        else { r -= I_O; W = P.win; gv = P.g2; ldw = DIN; c0 = 4608; K = D; k0 = 64 * r; WT = P.WIN; drow0 = 8704; }
        p0_transpose_item(W, ldw, c0, K, k0, WT, drow0, scr, lane, gv);
    }
}
__device__ __forceinline__ void p0_xn(const float* x, bf16* XB, float* RS, int gw, int NGW, int lane) {
    for (int m = gw; m < M; m += NGW) {
        const f32x4* xr = (const f32x4*)(x + (size_t)m * D) + lane; f32x4 v[8]; float s = 0.f;
#pragma unroll
        for (int j = 0; j < 8; ++j) { v[j] = __builtin_nontemporal_load(xr + 64 * j); s += (v[j].x * v[j].x + v[j].y * v[j].y) + (v[j].z * v[j].z + v[j].w * v[j].w); }
        const float ms = wave_sum(s) * (1.f / D) + EPS, rstd = rsqrtf(ms);
        u32x2* o = (u32x2*)(XB + (size_t)m * D) + lane;
#pragma unroll
        for (int j = 0; j < 8; ++j) { u32x2 w; w.x = cvtpk(v[j].x * rstd, v[j].y * rstd); w.y = cvtpk(v[j].z * rstd, v[j].w * rstd); o[64 * j] = w; }
        if (lane == 0) RS[m] = sqrtf(ms);
    }
}

constexpr int HP = 2048;
template <bool OUT_F32, bool GATES>
__device__ __forceinline__ void row_phase(const bf16* src, const bf16* resid, const float* rms_in, void* outp, float* rms_out, float scale, const float* g_post, const float* g_next,
                                          const float* win, float* G, LAS unsigned char* lds, int gw, int NGW, int tid, int lane) {
    if (GATES) {
        for (int idx = tid; idx < 4096; idx += NWAVES * 64) { const int k = idx >> 1, hf = idx & 1; const f32x4 v = *(const f32x4*)(win + (size_t)k * DIN + 4608 + hf * 4);
            *(LAS f32x4*)(lds + k * 32 + (k >> 3) * 16 + hf * 16) = v; }
        __syncthreads();
    }
    for (int m = gw; m < M; m += NGW) {
        int ln = lane; asm volatile("" : "+v"(ln));
        const v4u* sr = (const v4u*)(src + (size_t)m * D) + ln; const v4u* rr = (const v4u*)(resid + (size_t)m * D) + ln; v4u sw[4], rw[4];
#pragma unroll
        for (int j = 0; j < 4; ++j) sw[j] = __builtin_nontemporal_load(sr + 64 * j);
#pragma unroll
        for (int j = 0; j < 4; ++j) rw[j] = __builtin_nontemporal_load(rr + 64 * j);
        const float rin = rms_in[m];
        float f[4][8]; float s = 0.f;
#pragma unroll
        for (int j = 0; j < 4; ++j) { f[j][0] = bflo(sw[j].x); f[j][1] = bfhi(sw[j].x); f[j][2] = bflo(sw[j].y); f[j][3] = bfhi(sw[j].y); f[j][4] = bflo(sw[j].z); f[j][5] = bfhi(sw[j].z); f[j][6] = bflo(sw[j].w); f[j][7] = bfhi(sw[j].w);
#pragma unroll
            for (int e = 0; e < 8; ++e) s += f[j][e] * f[j][e]; }
        const float rstd = rsqrtf(wave_sum(s) * (1.f / D) + EPS) * scale;
        float s2 = 0.f;
#pragma unroll
        for (int j = 0; j < 4; ++j) { const f32x4 ga_ = ((const f32x4*)g_post)[128 * j + 2 * ln], gb_ = ((const f32x4*)g_post)[128 * j + 2 * ln + 1];
            f[j][0] = bflo(rw[j].x) * rin + f[j][0] * rstd * ga_.x; f[j][1] = bfhi(rw[j].x) * rin + f[j][1] * rstd * ga_.y; f[j][2] = bflo(rw[j].y) * rin + f[j][2] * rstd * ga_.z; f[j][3] = bfhi(rw[j].y) * rin + f[j][3] * rstd * ga_.w;
            f[j][4] = bflo(rw[j].z) * rin + f[j][4] * rstd * gb_.x; f[j][5] = bfhi(rw[j].z) * rin + f[j][5] * rstd * gb_.y; f[j][6] = bflo(rw[j].w) * rin + f[j][6] * rstd * gb_.z; f[j][7] = bfhi(rw[j].w) * rin + f[j][7] * rstd * gb_.w;
            if (OUT_F32) { f32x4* oo = (f32x4*)((float*)outp + (size_t)m * D) + 2 * ln; __builtin_nontemporal_store((f32x4){f[j][0], f[j][1], f[j][2], f[j][3]}, oo + 128 * j); __builtin_nontemporal_store((f32x4){f[j][4], f[j][5], f[j][6], f[j][7]}, oo + 128 * j + 1); }
#pragma unroll
            for (int e = 0; e < 8; ++e) s2 += f[j][e] * f[j][e]; }
        if (!OUT_F32) {
            const float ms2 = wave_sum(s2) * (1.f / D) + EPS, rstd2 = rsqrtf(ms2);
            if (ln == 0) rms_out[m] = sqrtf(ms2);
            v4u* o = (v4u*)((bf16*)outp + (size_t)m * D) + ln;
#pragma unroll
            for (int j = 0; j < 4; ++j) {
#pragma unroll
                for (int e = 0; e < 8; ++e) f[j][e] *= rstd2;
                v4u w; w.x = cvtpk(f[j][0], f[j][1]); w.y = cvtpk(f[j][2], f[j][3]); w.z = cvtpk(f[j][4], f[j][5]); w.w = cvtpk(f[j][6], f[j][7]); o[64 * j] = w; }
            if (GATES) {
                float ga[8];
#pragma unroll
                for (int c = 0; c < 8; ++c) ga[c] = 0.f;
#pragma unroll
                for (int j = 0; j < 4; ++j) { const f32x4 ga_ = ((const f32x4*)g_next)[128 * j + 2 * ln], gb_ = ((const f32x4*)g_next)[128 * j + 2 * ln + 1];
                    f[j][0] *= ga_.x; f[j][1] *= ga_.y; f[j][2] *= ga_.z; f[j][3] *= ga_.w; f[j][4] *= gb_.x; f[j][5] *= gb_.y; f[j][6] *= gb_.z; f[j][7] *= gb_.w;
#pragma unroll
                    for (int e = 0; e < 8; ++e) { const LAS unsigned char* p = lds + 17408 * j + 272 * ln + 32 * e; const f32x4 w0 = *(const LAS f32x4*)p, w1 = *(const LAS f32x4*)(p + 16); const float uu = f[j][e];
                        ga[0] += uu * w0.x; ga[1] += uu * w0.y; ga[2] += uu * w0.z; ga[3] += uu * w0.w; ga[4] += uu * w1.x; ga[5] += uu * w1.y; ga[6] += uu * w1.z; ga[7] += uu * w1.w; } }
#pragma unroll
                for (int c = 0; c < 8; ++c) ga[c] = wave_sum(ga[c]);
                if (ln == 0) { *(f32x4*)(G + (size_t)m * 8) = (f32x4){ga[0], ga[1], ga[2], ga[3]}; *(f32x4*)(G + (size_t)m * 8 + 4) = (f32x4){ga[4], ga[5], ga[6], ga[7]}; }
            }
        }
    }
}

constexpr int ATT_KS = 0, ATT_KROW = 144, ATT_VT = 39168, ATT_VROW = 560;
__device__ __forceinline__ void attn_unit(LAS unsigned char* lds, const bf16* Z1, bf16* ATT, const float* sinks, int unit, int tid) {
    const int lane = tid & 63, w = tid >> 6, l15 = lane & 15, g = lane >> 4;
    const int b = unit >> 6, qb = (unit >> 2) & 15, kvh = unit & 3;
    LAS unsigned char* Ks = lds + ATT_KS; LAS unsigned char* Vt = lds + ATT_VT;
    const size_t tok0 = (size_t)b * SEQ + qb * 128;
#pragma unroll
    for (int i = 0; i < 4; ++i) { const int id = tid + 512 * i, key = id >> 3, part = id & 7;
        v4u kv = (v4u){0u, 0u, 0u, 0u}, vv = (v4u){0u, 0u, 0u, 0u};
        if (qb > 0 || key >= 128) { const bf16* rowp = Z1 + (tok0 + key - 128) * NZ1; kv = *(const v4u*)(rowp + 1024 + kvh * 64 + part * 8); vv = *(const v4u*)(rowp + 1280 + kvh * 64 + part * 8); }
        *(LAS v4u*)(Ks + key * ATT_KROW + part * 16) = kv;
        LAS unsigned short* vt = (LAS unsigned short*)(Vt + (part * 8) * ATT_VROW + key * 2);
        vt[0 * 280] = (unsigned short)(vv.x & 0xffffu); vt[1 * 280] = (unsigned short)(vv.x >> 16); vt[2 * 280] = (unsigned short)(vv.y & 0xffffu); vt[3 * 280] = (unsigned short)(vv.y >> 16);
        vt[4 * 280] = (unsigned short)(vv.z & 0xffffu); vt[5 * 280] = (unsigned short)(vv.z >> 16); vt[6 * 280] = (unsigned short)(vv.w & 0xffffu); vt[7 * 280] = (unsigned short)(vv.w >> 16); }
    if (tid < 128) { const int key = 256 + (tid >> 3), part = tid & 7; *(LAS v4u*)(Ks + key * ATT_KROW + part * 16) = (v4u){0u, 0u, 0u, 0u}; }
    else if (tid < 256) { const int t2 = tid - 128, d = t2 >> 1, hf = t2 & 1; *(LAS v4u*)(Vt + d * ATT_VROW + 512 + hf * 16) = (v4u){0u, 0u, 0u, 0u}; }
    __syncthreads();
    const int hq = kvh * 4 + (w >> 1);
    const float slope = exp2f(-0.5f * (float)(hq + 1)), sink = sinks[hq];
    const int d0 = l15 - 4 * g; const float sb = slope * (float)(d0 + 128);
    for (int st = 0; st < 4; ++st) {
        const int r0 = (w & 1) * 64 + st * 16, T0 = r0 >> 4;
        const bf16* qrow = Z1 + (tok0 + r0 + l15) * NZ1 + hq * 64 + g * 8;
        const bf16x8 bq0 = *(const bf16x8*)qrow, bq1 = *(const bf16x8*)(qrow + 32);
        f32x4 s[9]; float mx = -INFINITY;
#pragma unroll
        for (int kt = 0; kt < 9; ++kt) { f32x4 a = (f32x4){0.f, 0.f, 0.f, 0.f}; const LAS unsigned char* kp = Ks + ((T0 + kt) * 16 + l15) * ATT_KROW + g * 16;
            a = mfma16(*(const LAS bf16x8*)kp, bq0, a); a = mfma16(*(const LAS bf16x8*)(kp + 64), bq1, a);
            const bool tile_ok = (qb > 0) || (T0 + kt >= 8);
#pragma unroll
            for (int j = 0; j < 4; ++j) { float sv = a[j] * 0.125f + (slope * (float)(16 * kt + j) - sb);
                bool valid = tile_ok; if (kt == 0) valid = valid && (d0 < j); if (kt == 8) valid = valid && (d0 >= j);
                sv = valid ? sv : -INFINITY; s[kt][j] = sv; mx = fmaxf(mx, sv); } }
        mx = fmaxf(mx, __shfl_xor(mx, 16)); mx = fmaxf(mx, __shfl_xor(mx, 32)); mx = fmaxf(mx, sink);
        float ls = 0.f;
#pragma unroll
        for (int kt = 0; kt < 9; ++kt)
#pragma unroll
            for (int j = 0; j < 4; ++j) { const float p = __expf(s[kt][j] - mx); s[kt][j] = p; ls += p; }
        ls += __shfl_xor(ls, 16); ls += __shfl_xor(ls, 32);
        const float inv = 1.0f / (ls + __expf(sink - mx));
        f32x4 o[4];
#pragma unroll
        for (int dt = 0; dt < 4; ++dt) o[dt] = (f32x4){0.f, 0.f, 0.f, 0.f};
#pragma unroll
        for (int pp = 0; pp < 5; ++pp) { v4u pw; pw.x = cvtpk(s[2 * pp][0], s[2 * pp][1]); pw.y = cvtpk(s[2 * pp][2], s[2 * pp][3]);
            if (pp < 4) { pw.z = cvtpk(s[(pp < 4) ? 2 * pp + 1 : 0][0], s[(pp < 4) ? 2 * pp + 1 : 0][1]); pw.w = cvtpk(s[(pp < 4) ? 2 * pp + 1 : 0][2], s[(pp < 4) ? 2 * pp + 1 : 0][3]); } else { pw.z = 0u; pw.w = 0u; }
            const bf16x8 bp = __builtin_bit_cast(bf16x8, pw);
#pragma unroll
            for (int dt = 0; dt < 4; ++dt) { const LAS unsigned char* vp = Vt + (dt * 16 + l15) * ATT_VROW + ((T0 + 2 * pp) * 16 + g * 4) * 2; const u32x2 lo = *(const LAS u32x2*)vp, hi = *(const LAS u32x2*)(vp + 32);
                const v4u av = (v4u){lo.x, lo.y, hi.x, hi.y}; o[dt] = mfma16(__builtin_bit_cast(bf16x8, av), bp, o[dt]); } }
        bf16* orow = ATT + (tok0 + r0 + l15) * 1024 + hq * 64 + g * 4;
#pragma unroll
        for (int dt = 0; dt < 4; ++dt) { u32x2 wv; wv.x = cvtpk(o[dt][0] * inv, o[dt][1] * inv); wv.y = cvtpk(o[dt][2] * inv, o[dt][3] * inv); *(u32x2*)(orow + dt * 16) = wv; }
    }
    __syncthreads();
}

__device__ __forceinline__ void conv_prepass(const bf16* Z1, const float* conv_w, const float* conv_b, bf16* QKc, int gtid, int nthreads) {
    for (int it = gtid; it < (M / 4) * 128; it += nthreads) {
        const int cgp = it & 127, tquad = it >> 7, ccol = cgp * 8, tok0 = tquad * 4, ts = tok0 & (SEQ - 1);
        v4u xr[7];
#pragma unroll
        for (int r = 0; r < 7; ++r) xr[r] = (ts - 3 + r >= 0) ? *(const v4u*)(Z1 + (size_t)(tok0 - 3 + r) * NZ1 + 1536 + ccol) : (v4u){0u, 0u, 0u, 0u};
        float cw[4][8], cb[8];
#pragma unroll
        for (int j = 0; j < 4; ++j) { const f32x4 a = *(const f32x4*)(conv_w + j * 1024 + ccol), c2 = *(const f32x4*)(conv_w + j * 1024 + ccol + 4);
            cw[j][0] = a.x; cw[j][1] = a.y; cw[j][2] = a.z; cw[j][3] = a.w; cw[j][4] = c2.x; cw[j][5] = c2.y; cw[j][6] = c2.z; cw[j][7] = c2.w; }
        { const f32x4 a = *(const f32x4*)(conv_b + ccol), c2 = *(const f32x4*)(conv_b + ccol + 4); cb[0] = a.x; cb[1] = a.y; cb[2] = a.z; cb[3] = a.w; cb[4] = c2.x; cb[5] = c2.y; cb[6] = c2.z; cb[7] = c2.w; }
        const float osc = (ccol >= 512) ? 0.08838834764831845f : 1.0f;
#pragma unroll
        for (int tt = 0; tt < 4; ++tt) { float y[8];
#pragma unroll
            for (int e = 0; e < 8; ++e) y[e] = cb[e];
#pragma unroll
            for (int j = 0; j < 4; ++j) { const v4u xx = xr[tt + j];
                y[0] += cw[j][0] * bflo(xx.x); y[1] += cw[j][1] * bfhi(xx.x); y[2] += cw[j][2] * bflo(xx.y); y[3] += cw[j][3] * bfhi(xx.y);
                y[4] += cw[j][4] * bflo(xx.z); y[5] += cw[j][5] * bfhi(xx.z); y[6] += cw[j][6] * bflo(xx.w); y[7] += cw[j][7] * bfhi(xx.w); }
#pragma unroll
            for (int e = 0; e < 8; ++e) y[e] = y[e] * sigmf(y[e]) * osc;
            v4u o; o.x = cvtpk(y[0], y[1]); o.y = cvtpk(y[2], y[3]); o.z = cvtpk(y[4], y[5]); o.w = cvtpk(y[6], y[7]);
            *(v4u*)(QKc + (size_t)(tok0 + tt) * 1024 + ccol) = o; }
    }
}

constexpr int ML_QS = 0, ML_KS = 34816, ML_KWT = 52224, ML_VT = 70656, ML_PS = 84480, ML_CT = 102912, ML_U = 129024, ML_A1 = 137216, ML_MT = 145408,
              ML_BL = 153600, ML_CMX = 153728, ML_MIN = 153856, ML_MNEW = 153984, ML_DEC = 154112;
constexpr int ML_QS_SZ = 17408, ML_VT_SZ = 6912, ML_PS_SZ = 9216, ML_CT_SZ = 13056;
__device__ __forceinline__ void mlstm_item(LAS unsigned char* lds, const bf16* Z1, const bf16* QKc, const float* G, const float* bi, const float* bfg,
                                           bf16* HT, float* SS, int item, int tid) {
    const int lane = tid & 63, w = __builtin_amdgcn_readfirstlane(tid >> 6), l15 = lane & 15, g = lane >> 4;
    const int bh = item >> 3, b = bh >> 2, h = bh & 3, slice = item & 7, dv0 = slice * 32;
    LAS float* U = (LAS float*)(lds + ML_U); LAS float* A1 = (LAS float*)(lds + ML_A1); LAS float* MT = (LAS float*)(lds + ML_MT);
    LAS float* BL = (LAS float*)(lds + ML_BL); LAS float* CMX = (LAS float*)(lds + ML_CMX); LAS float* MIN = (LAS float*)(lds + ML_MIN); LAS float* MNEW = (LAS float*)(lds + ML_MNEW); LAS float* DEC = (LAS float*)(lds + ML_DEC);
    const size_t tokb = (size_t)b * SEQ;
    { const float bih = bi[h], bfh = bfg[h];
      for (int c = w; c < 32; c += 8) { const size_t tok = tokb + c * 64 + lane;
        const float ip = G[tok * 8 + h] + bih, fp = G[tok * 8 + 4 + h] + bfh;
        const float lf = fminf(fp, 0.f) - log1pf(expf(-fabsf(fp)));
        float bt = lf;
#pragma unroll
        for (int o = 1; o < 64; o <<= 1) { const float t = __shfl_up(bt, o); if (lane >= o) bt += t; }
        const float u = ip - bt; float cm = u;
#pragma unroll
        for (int o = 1; o < 64; o <<= 1) { const float t = __shfl_up(cm, o); if (lane >= o) cm = fmaxf(cm, t); }
        A1[c * 64 + lane] = bt; U[c * 64 + lane] = u; MT[c * 64 + lane] = cm;
        if (lane == 63) { BL[c] = bt; CMX[c] = cm; } } }
    for (int i = tid; i < 2 * ML_PS_SZ / 16; i += 512) *(LAS v4u*)(lds + ML_PS + i * 16) = (v4u){0u, 0u, 0u, 0u};
    for (int i = tid; i < 2 * 16 * 72; i += 512) { const int bsel = i / (16 * 72), r = i % (16 * 72); ((LAS unsigned short*)(lds + ML_VT + bsel * ML_VT_SZ))[32 * 72 + r] = (r < 72) ? (unsigned short)0x3F80u : (unsigned short)0u; }
    __syncthreads();
    if (tid == 0) { float m = 0.f; for (int c = 0; c < 32; ++c) { MIN[c] = m; const float bl = BL[c]; const float mn = bl + fmaxf(m, CMX[c]); MNEW[c] = mn; DEC[c] = expf(bl + m - mn); m = mn; } }
    __syncthreads();
    for (int idx = tid; idx < 2048; idx += 512) { const int c = idx >> 6; const float bt = A1[idx], cm = MT[idx]; const float mt = bt + fmaxf(MIN[c], cm); A1[idx] = bt - mt; MT[idx] = mt; }
    const int tb = tid & 255, cg8 = tb & 31, tq = tb >> 5; const bool isk = cg8 >= 16;
    const int ccol = h * 128 + (cg8 & 15) * 8 + (isk ? 512 : 0);
    v4u xr[3][8], vr[3]; f32x4 C[2][3];
#pragma unroll
    for (int s3 = 0; s3 < 3; ++s3) {
#pragma unroll
        for (int r = 0; r < 8; ++r) xr[s3][r] = (v4u){0u, 0u, 0u, 0u};
        vr[s3] = (v4u){0u, 0u, 0u, 0u}; }
#pragma unroll
    for (int d2 = 0; d2 < 2; ++d2)
#pragma unroll
        for (int jt = 0; jt < 3; ++jt) C[d2][jt] = (f32x4){0.f, 0.f, 0.f, 0.f};
#define ML_LOAD(cc, SET) do { const int t0_ = (cc) * 64 + tq * 8; \
        _Pragma("unroll") for (int r_ = 0; r_ < 8; ++r_) xr[SET][r_] = *(const v4u*)(QKc + (tokb + t0_ + r_) * 1024 + ccol); \
        vr[SET] = *(const v4u*)(Z1 + (tokb + (cc) * 64 + (tb >> 2)) * NZ1 + 2560 + h * 256 + dv0 + (tb & 3) * 8); } while (0)
    if (w >= 4) { ML_LOAD(0, 0); ML_LOAD(1, 1); ML_LOAD(2, 2); }
    __syncthreads();
#define ML_BAR() do { asm volatile("s_waitcnt lgkmcnt(0)" ::: "memory"); __builtin_amdgcn_s_barrier(); asm volatile("" ::: "memory"); } while (0)
    if (w >= 4) {
    for (int i3 = 0; i3 < 33; i3 += 3) {
#pragma unroll
    for (int u3 = 0; u3 < 3; ++u3) {
        const int i = i3 + u3, bo = i & 1, ic = (i < 32) ? i : 31;
            {
                LAS unsigned char* QSb = lds + ML_QS + bo * ML_QS_SZ; LAS unsigned short* VT16 = (LAS unsigned short*)(lds + ML_VT + bo * ML_VT_SZ);
                const float blc = BL[ic], mnc = MNEW[ic];
#pragma unroll
                for (int hh = 0; hh < 2; ++hh) { float y[4][8];
#pragma unroll
                    for (int tt = 0; tt < 4; ++tt) { const v4u xx = xr[u3][hh * 4 + tt];
                        y[tt][0] = bflo(xx.x); y[tt][1] = bfhi(xx.x); y[tt][2] = bflo(xx.y); y[tt][3] = bfhi(xx.y); y[tt][4] = bflo(xx.z); y[tt][5] = bfhi(xx.z); y[tt][6] = bflo(xx.w); y[tt][7] = bfhi(xx.w); }
                    const int tl = tq * 8 + hh * 4;
                    if (!isk) {
#pragma unroll
                        for (int tt = 0; tt < 4; ++tt) *(LAS v4u*)(QSb + (tl + tt) * 272 + cg8 * 16) = xr[u3][hh * 4 + tt];
                    } else {
                        float ws4[4];
#pragma unroll
                        for (int tt = 0; tt < 4; ++tt) ws4[tt] = __expf(blc + U[ic * 64 + tl + tt] - mnc);
#pragma unroll
                        for (int tt = 0; tt < 4; ++tt) *(LAS v4u*)(lds + ML_KS + (tl + tt) * 272 + (cg8 - 16) * 16) = xr[u3][hh * 4 + tt];
#pragma unroll
                        for (int e = 0; e < 8; ++e) { u32x2 o; o.x = cvtpk(y[0][e] * ws4[0], y[1][e] * ws4[1]); o.y = cvtpk(y[2][e] * ws4[2], y[3][e] * ws4[3]);
                            *(LAS u32x2*)(lds + ML_KWT + ((cg8 - 16) * 8 + e) * 144 + tl * 2) = o; }
                    } }
                { LAS unsigned short* vt = VT16 + ((tb & 3) * 8) * 72 + (tb >> 2);
                  vt[0 * 72] = (unsigned short)(vr[u3].x & 0xffffu); vt[1 * 72] = (unsigned short)(vr[u3].x >> 16); vt[2 * 72] = (unsigned short)(vr[u3].y & 0xffffu); vt[3 * 72] = (unsigned short)(vr[u3].y >> 16);
                  vt[4 * 72] = (unsigned short)(vr[u3].z & 0xffffu); vt[5 * 72] = (unsigned short)(vr[u3].z >> 16); vt[6 * 72] = (unsigned short)(vr[u3].w & 0xffffu); vt[7 * 72] = (unsigned short)(vr[u3].w >> 16); }
                ML_LOAD((i + 3 < 32) ? i + 3 : 31, u3);
            }
        ML_BAR();
        if (i < 32) {
            {
                LAS unsigned char* CTb = lds + ML_CT + bo * ML_CT_SZ; const LAS unsigned char* VTb = lds + ML_VT + bo * ML_VT_SZ; const int dk0 = 32 * (w - 4);
#pragma unroll
                for (int d2 = 0; d2 < 2; ++d2)
#pragma unroll
                    for (int jt = 0; jt < 3; ++jt) { u32x2 o; o.x = cvtpk(C[d2][jt][0], C[d2][jt][1]); o.y = cvtpk(C[d2][jt][2], C[d2][jt][3]); *(LAS u32x2*)(CTb + (jt * 16 + l15) * 272 + (dk0 + 16 * d2 + g * 4) * 2) = o; }
                const float dec = DEC[i];
#pragma unroll
                for (int d2 = 0; d2 < 2; ++d2)
#pragma unroll
                    for (int jt = 0; jt < 3; ++jt) C[d2][jt] = C[d2][jt] * dec;
#pragma unroll
                for (int ks = 0; ks < 2; ++ks) { bf16x8 bv[3];
#pragma unroll
                    for (int jt = 0; jt < 3; ++jt) bv[jt] = *(const LAS bf16x8*)(VTb + (jt * 16 + l15) * 144 + ks * 64 + g * 16);
#pragma unroll
                    for (int d2 = 0; d2 < 2; ++d2) { const bf16x8 a = *(const LAS bf16x8*)(lds + ML_KWT + (dk0 + 16 * d2 + l15) * 144 + ks * 64 + g * 16);
#pragma unroll
                        for (int jt = 0; jt < 3; ++jt) C[d2][jt] = mfma16(a, bv[jt], C[d2][jt]); } }
            }
        }
        ML_BAR();
    } }
    } else {
    for (int i = 0; i <= 32; ++i) {
        const int bo = i & 1;
        if (i >= 1) {
            const int c = i - 1, co = c & 1;
            const LAS unsigned char* QSb = lds + ML_QS + co * ML_QS_SZ; const LAS unsigned char* VTb = lds + ML_VT + co * ML_VT_SZ; const LAS unsigned char* PSb = lds + ML_PS + co * ML_PS_SZ; const LAS unsigned char* CTb = lds + ML_CT + co * ML_CT_SZ;
            f32x4 y1[3], y2[3];
#pragma unroll
            for (int jt = 0; jt < 3; ++jt) { y1[jt] = (f32x4){0.f, 0.f, 0.f, 0.f}; y2[jt] = (f32x4){0.f, 0.f, 0.f, 0.f}; }
#pragma unroll
            for (int ks = 0; ks < 2; ++ks) { const bf16x8 bp = *(const LAS bf16x8*)(PSb + (w * 16 + l15) * 144 + ks * 64 + g * 16);
#pragma unroll
                for (int jt = 0; jt < 3; ++jt) y1[jt] = mfma16(*(const LAS bf16x8*)(VTb + (jt * 16 + l15) * 144 + ks * 64 + g * 16), bp, y1[jt]); }
#pragma unroll
            for (int kk = 0; kk < 4; ++kk) { const bf16x8 bq = *(const LAS bf16x8*)(QSb + (w * 16 + l15) * 272 + kk * 64 + g * 16);
#pragma unroll
                for (int jt = 0; jt < 3; ++jt) y2[jt] = mfma16(*(const LAS bf16x8*)(CTb + (jt * 16 + l15) * 272 + kk * 64 + g * 16), bq, y2[jt]); }
            const int t_ = w * 16 + l15; const float iw = __expf(A1[c * 64 + t_] + MIN[c]), en = __expf(-MT[c * 64 + t_]);
            const float den = __shfl(y1[2][0] + iw * y2[2][0], l15);
            const float inv = 1.0f / fmaxf(fabsf(den), en);
            float hv[2][4]; float ss = 0.f;
#pragma unroll
            for (int jt = 0; jt < 2; ++jt)
#pragma unroll
                for (int q = 0; q < 4; ++q) { hv[jt][q] = (y1[jt][q] + iw * y2[jt][q]) * inv; ss += hv[jt][q] * hv[jt][q]; }
            ss += __shfl_xor(ss, 16); ss += __shfl_xor(ss, 32);
            const size_t tok = tokb + c * 64 + t_;
#pragma unroll
            for (int jt = 0; jt < 2; ++jt) { u32x2 o; o.x = cvtpk(hv[jt][0], hv[jt][1]); o.y = cvtpk(hv[jt][2], hv[jt][3]); *(u32x2*)(HT + tok * 1024 + h * 256 + dv0 + jt * 16 + g * 4) = o; }
            if (g == 0) SS[(tok * 4 + h) * 8 + slice] = ss;
        }
        ML_BAR();
        if (i < 32) {
            {
                const LAS unsigned char* QSb = lds + ML_QS + bo * ML_QS_SZ; LAS unsigned short* PS16 = (LAS unsigned short*)(lds + ML_PS + bo * ML_PS_SZ);
                const int ntile = (w < 2) ? 2 : 3;
                for (int q2 = 0; q2 < ntile; ++q2) {
                    int tt, st;
                    if (w == 0) { tt = 3; st = q2; } else if (w == 1) { tt = 3; st = 2 + q2; } else if (w == 2) { tt = 2; st = q2; } else { tt = (q2 < 2) ? 1 : 0; st = (q2 < 2) ? q2 : 0; }
                    f32x4 a = (f32x4){0.f, 0.f, 0.f, 0.f};
#pragma unroll
                    for (int kk = 0; kk < 4; ++kk) a = mfma16(*(const LAS bf16x8*)(QSb + (tt * 16 + l15) * 272 + kk * 64 + g * 16), *(const LAS bf16x8*)(lds + ML_KS + (st * 16 + l15) * 272 + kk * 64 + g * 16), a);
                    const int s_ = st * 16 + l15; const float us = U[i * 64 + s_];
#pragma unroll
                    for (int q = 0; q < 4; ++q) { const int t_ = tt * 16 + g * 4 + q; const float p = (s_ <= t_) ? a[q] * __expf(A1[i * 64 + t_] + us) : 0.f; PS16[t_ * 72 + s_] = (unsigned short)(cvtpk(p, 0.f) & 0xffffu); } }
            }
        }
        ML_BAR();
    }
    }
#undef ML_BAR
#undef ML_LOAD
}

__device__ __forceinline__ void headnorm_phase(bf16* HT, const float* SS, const bf16* Z1, const float* mg, int gw, int NGW, int lane) {
    for (int m = gw; m < M; m += NGW) {
#pragma unroll
        for (int jj = 0; jj < 2; ++jj) { const int ci = lane + 64 * jj, head = ci >> 5;
            const f32x4 s0 = *(const f32x4*)(SS + ((size_t)m * 4 + head) * 8), s1 = *(const f32x4*)(SS + ((size_t)m * 4 + head) * 8 + 4);
            const float r = rsqrtf(((s0.x + s0.y) + (s0.z + s0.w) + (s1.x + s1.y) + (s1.z + s1.w)) * (1.f / 256.f) + EPS);
            const v4u ht = __builtin_nontemporal_load((const v4u*)(HT + (size_t)m * 1024 + ci * 8)), mo = __builtin_nontemporal_load((const v4u*)(Z1 + (size_t)m * NZ1 + 3584 + ci * 8));
            const f32x4 g0 = *(const f32x4*)(mg + ci * 8), g1 = *(const f32x4*)(mg + ci * 8 + 4);
            v4u o;
            o.x = cvtpk(sigmf(bflo(mo.x)) * bflo(ht.x) * r * g0.x, sigmf(bfhi(mo.x)) * bfhi(ht.x) * r * g0.y);
            o.y = cvtpk(sigmf(bflo(mo.y)) * bflo(ht.y) * r * g0.z, sigmf(bfhi(mo.y)) * bfhi(ht.y) * r * g0.w);
            o.z = cvtpk(sigmf(bflo(mo.z)) * bflo(ht.z) * r * g1.x, sigmf(bfhi(mo.z)) * bfhi(ht.z) * r * g1.y);
            o.w = cvtpk(sigmf(bflo(mo.w)) * bflo(ht.w) * r * g1.z, sigmf(bfhi(mo.w)) * bfhi(ht.w) * r * g1.w);
            *(v4u*)(HT + (size_t)m * 1024 + ci * 8) = o; }
    }
}

#ifndef PROBE_DUP
#define PROBE_DUP 0
#endif
#ifndef STAGGER_TICKS
#define STAGGER_TICKS 900
#endif
#ifndef PG8_ALIGNV
#define PG8_ALIGNV true
#endif
#ifndef PG8_SP2V
#define PG8_SP2V true
#endif
#ifndef USE_CG_ALL
#define USE_CG_ALL 0
#endif
struct Args { const float* in[23]; float* out; unsigned char* ws; };
enum { I_X = 0, I_F1PRE, I_F1WG, I_F1WU, I_F1WD, I_F1POST, I_MIXPRE, I_WIN, I_CONVW, I_CONVB, I_SINKS, I_BI, I_BF, I_MHG, I_WA, I_WM, I_WO, I_MIXPOST, I_F2PRE, I_F2WG, I_F2WU, I_F2WD, I_F2POST };

__global__ void __launch_bounds__(NWAVES * 64, 2) hybrid_fwd(Args args) {
    extern __shared__ __attribute__((aligned(16))) unsigned char lds_raw[];
    cg::grid_group grid = cg::this_grid();
    LAS unsigned char* lds = (LAS unsigned char*)lds_raw;
    volatile LAS unsigned* MISC = (volatile LAS unsigned*)(lds + MISC_OFF);
    const int wave = __builtin_amdgcn_readfirstlane((int)threadIdx.x >> 6);
#define lane (cur_lane())
#define tid (wave * 64 + cur_lane())
    const int G = gridDim.x, bx = blockIdx.x;
    const int vcu = (G % 8 == 0) ? (bx % 8) * (G / 8) + bx / 8 : bx;
    const int gw = vcu * NWAVES + wave, NGW = G * NWAVES;
    unsigned char* ws = args.ws; unsigned char* ob = (unsigned char*)args.out;
    for (int u = tid; u < (LDS_BYTES - LDS_CTRL) / 4; u += NWAVES * 64) ((LAS unsigned*)(lds + LDS_CTRL))[u] = 0u;
    __syncthreads();
#if !USE_CG_ALL
    XcdBarrier bar = xcd_barrier_post((unsigned*)(ws + WS_CTL), MISC + 8);
#endif

#if USE_CG_ALL
#define SEAM(first) grid.sync()
#else
#define SEAM(first) do { if (first) grid.sync(); else xcd_barrier(bar); } while (0)
#endif
#define GEMM_PHASE(MODE, PAIR, Aptr, Bptr, Kk, Nn, Optr, LDC, O2ptr, GTptr) GEMM_PHASE_W(MODE, PAIR, Aptr, Bptr, Kk, Nn, Optr, LDC, O2ptr, GTptr, 8)
#define GEMM_PHASE_W(MODE, PAIR, Aptr, Bptr, Kk, Nn, Optr, LDC, O2ptr, GTptr, WG) do { \
        pg8::Gemm g_; g_.A = (const bf16*)(Aptr); g_.Bt = (const bf16*)(Bptr); g_.M = M; g_.N = (Nn); g_.K = (Kk); \
        pg8::GenSched<PAIR> S_; S_.so.init(M, (Nn), G, bx); S_.so.wgm = (WG); \
        pg8::GenEpi<MODE> E_; E_.O = (bf16*)(Optr); E_.ldc = (LDC); E_.O2 = (bf16*)(O2ptr); E_.Gt = (const bf16*)(GTptr); \
        pg8::gemm_phase<pg8::GenEpi<MODE>, pg8::GenSched<PAIR>, PG8_ALIGNV, PG8_SP2V>(lds, g_, S_, E_, wave); } while (0)

    {
        P0Ptrs P; P.f1g = args.in[I_F1WG]; P.f1u = args.in[I_F1WU]; P.f1d = args.in[I_F1WD]; P.win = args.in[I_WIN]; P.wa = args.in[I_WA]; P.wm = args.in[I_WM]; P.wo = args.in[I_WO];
        P.f2g = args.in[I_F2WG]; P.f2u = args.in[I_F2WU]; P.f2d = args.in[I_F2WD]; P.g1 = args.in[I_F1PRE]; P.g2 = args.in[I_MIXPRE]; P.g3 = args.in[I_F2PRE];
        P.F1GU = (bf16*)(ob + OUT_F1GU); P.F1D = (bf16*)(ob + OUT_F1D); P.WIN = (bf16*)(ws + WS_WIN); P.WUP = (bf16*)(ws + WS_WUP); P.WOUT = (bf16*)(ws + WS_WOUT); P.F2GU = (bf16*)(ws + WS_F2GU); P.F2D = (bf16*)(ws + WS_F2D);
        p0_xn(args.in[I_X], (bf16*)(ws + WS_XA), (float*)(ws + WS_RS), gw, NGW, lane);
        p0_weights(P, lds, gw, NGW, wave, lane);
#if PROBE_DUP == 1
        __syncthreads(); p0_xn(args.in[I_X], (bf16*)(ws + WS_XA), (float*)(ws + WS_RS), gw, NGW, lane);
        p0_weights(P, lds, gw, NGW, wave, lane);
#endif
    }
    SEAM(1);
    for (int rep = 0; rep < (PROBE_DUP == 5 ? 2 : 1); ++rep)
    GEMM_PHASE(1, 0, ws + WS_XA, ob + OUT_F1GU, D, 2 * FF, ws + WS_H, FF, nullptr, nullptr);
    SEAM(0);
    for (int rep = 0; rep < (PROBE_DUP == 6 ? 2 : 1); ++rep)
    GEMM_PHASE_W(0, 0, ws + WS_H, ob + OUT_F1D, FF, D, ws + WS_F, D, nullptr, nullptr, 4);
    SEAM(0);
    row_phase<false, false>((const bf16*)(ws + WS_F), (const bf16*)(ws + WS_XA), (const float*)(ws + WS_RS), args.out, (float*)(ws + WS_RS) + M, 0.5f, args.in[I_F1POST], nullptr, nullptr, nullptr, lds, gw, NGW, tid, lane);
#if PROBE_DUP == 4
    __syncthreads(); row_phase<false, false>((const bf16*)(ws + WS_F), (const bf16*)(ws + WS_XA), (const float*)(ws + WS_RS), args.out, (float*)(ws + WS_RS) + M, 0.5f, args.in[I_F1POST], nullptr, nullptr, nullptr, lds, gw, NGW, tid, lane);
#endif
    SEAM(0);
    GEMM_PHASE(2, 0, ob, ws + WS_WIN, D, NZG, ws + WS_Z1, NZ1, ws + WS_Z2, ws + WS_G);
    SEAM(0);
    for (int rep = 0; rep < (PROBE_DUP == 2 ? 2 : 1); ++rep)
    for (int u = vcu; u < 512; u += G) attn_unit(lds, (const bf16*)(ws + WS_Z1), (bf16*)(ws + WS_XA), args.in[I_SINKS], u, tid);
    conv_prepass((const bf16*)(ws + WS_Z1), args.in[I_CONVW], args.in[I_CONVB], (bf16*)(ob + 64 * MiB), vcu * (NWAVES * 64) + tid, G * NWAVES * 64);
    SEAM(0);
    for (int rep = 0; rep < (PROBE_DUP == 3 ? 2 : 1); ++rep)
    for (int it = vcu; it < 256; it += G) { mlstm_item(lds, (const bf16*)(ws + WS_Z1), (const bf16*)(ob + 64 * MiB), (const float*)(ws + WS_G), args.in[I_BI], args.in[I_BF], (bf16*)(ws + WS_XA) + (size_t)M * 1024, (float*)(ws + WS_SS), it, tid); __syncthreads(); }
    SEAM(0);
    headnorm_phase((bf16*)(ws + WS_XA) + (size_t)M * 1024, (const float*)(ws + WS_SS), (const bf16*)(ws + WS_Z1), args.in[I_MHG], gw, NGW, lane);
    SEAM(0);
    for (int rep = 0; rep < (PROBE_DUP == 7 ? 2 : 1); ++rep)
    GEMM_PHASE_W(3, 1, ws + WS_XA, ws + WS_WUP, 1024, D, ws + WS_Y, D, nullptr, ws + WS_Z2, 4);
    SEAM(0);
    for (int rep = 0; rep < (PROBE_DUP == 8 ? 2 : 1); ++rep)
    GEMM_PHASE_W(0, 0, ws + WS_Y, ws + WS_WOUT, D, D, ob + 64 * MiB, D, nullptr, nullptr, 4);
    SEAM(0);
    row_phase<false, false>((const bf16*)(ob + 64 * MiB), (const bf16*)ob, (const float*)(ws + WS_RS) + M, ws + WS_H2, (float*)(ws + WS_RS) + 2 * M, 1.0f, args.in[I_MIXPOST], nullptr, nullptr, nullptr, lds, gw, NGW, tid, lane);
    SEAM(0);
    GEMM_PHASE(1, 0, ws + WS_H2, ws + WS_F2GU, D, 2 * FF, ws + WS_H, FF, nullptr, nullptr);
    SEAM(0);
    GEMM_PHASE_W(0, 0, ws + WS_H, ws + WS_F2D, FF, D, ws + WS_XA, D, nullptr, nullptr, 4);
    SEAM(0);
    row_phase<true, false>((const bf16*)(ws + WS_XA), (const bf16*)(ws + WS_H2), (const float*)(ws + WS_RS) + 2 * M, args.out, nullptr, 0.5f, args.in[I_F2POST], nullptr, nullptr, nullptr, lds, gw, NGW, tid, lane);
}
#undef lane
#undef tid

extern "C" void kernel_launch(void* const* d_in, const int* in_sizes, int n_in, void* d_out, int out_size, void* d_ws, size_t ws_size, hipStream_t stream) {
    static int grid = 0;
    if (grid == 0) {
        if (n_in != 23 || in_sizes[0] != M * D || out_size != M * D || ws_size < WS_END) { fprintf(stderr, "kernel_launch: unexpected shapes (n_in %d, in0 %d, out %d, ws %zu, need %zu)\n", n_in, n_in > 0 ? in_sizes[0] : -1, out_size, ws_size, (size_t)WS_END); grid = -1; return; }
        int dev = 0, cus = 0, per_cu = 0;
        if (hipGetDevice(&dev) != hipSuccess || hipDeviceGetAttribute(&cus, hipDeviceAttributeMultiprocessorCount, dev) != hipSuccess) { grid = -1; return; }
        if (hipFuncSetAttribute((const void*)hybrid_fwd, hipFuncAttributeMaxDynamicSharedMemorySize, LDS_BYTES) != hipSuccess) { fprintf(stderr, "kernel_launch: hipFuncSetAttribute failed\n"); grid = -1; return; }
        if (hipOccupancyMaxActiveBlocksPerMultiprocessor(&per_cu, (const void*)hybrid_fwd, NWAVES * 64, LDS_BYTES) != hipSuccess || per_cu < 1) { fprintf(stderr, "kernel_launch: occupancy query says %d\n", per_cu); per_cu = 1; }
        (void)hipGetLastError();
        grid = cus * per_cu;
    }
    if (grid < 0) return;
    (void)hipMemsetAsync((char*)d_ws + WS_CTL, 0, CTL_ZERO_BYTES, stream);
    Args a{};
    for (int i = 0; i < 23; ++i) a.in[i] = (const float*)d_in[i];
    a.out = (float*)d_out; a.ws = (unsigned char*)d_ws;
    void* kargs[] = {&a};
    hipError_t e = hipLaunchCooperativeKernel((const void*)hybrid_fwd, dim3(grid), dim3(NWAVES * 64), kargs, LDS_BYTES, stream);
    if (e != hipSuccess) fprintf(stderr, "kernel_launch: cooperative launch failed: %s (grid %d)\n", hipGetErrorString(e), grid);
}
```
